# Optimizing an MI355X kernel written in HIP

```python
import math
import jax, jax.numpy as jnp
from jax import lax
import numpy as np

D_MODEL = 1024
BATCH = 8
SEQ = 2048
DEPTH = 4

GRID_W = 64
CTX_LEN = 256
HEAD_DIM = 64
A_HEADS = 4
A_KV_HEADS = 2
A_BLOCK = 128
A_WINDOW = 128
ROPE_BASE = 10000.0
SSD_HEADS = 8
SSD_HEAD_DIM = 64
SSD_INNER = SSD_HEADS * SSD_HEAD_DIM
SSD_GROUPS = 2
SSD_STATE = 64
SSD_CONV = 5
SSD_CHUNK = 128
SSD_CONV_DIM = SSD_INNER + 2 * SSD_GROUPS * SSD_STATE
NA_HEADS = 4
NA_WIN_ROWS = 8
NA_WIN_COLS = 16
A_WIDTH = A_HEADS * HEAD_DIM
NA_WIDTH = NA_HEADS * HEAD_DIM
D_MIX = A_WIDTH + SSD_INNER + NA_WIDTH
A_IN = (A_HEADS + 2 * A_KV_HEADS) * HEAD_DIM
SSD_IN = SSD_INNER + SSD_CONV_DIM + 2 * SSD_HEADS
NA_IN = 3 * NA_WIDTH
N_IN = A_IN + SSD_IN + NA_IN
MOE_GROUPS = 4
MOE_EXPERTS = 8
MOE_TOPK = 2
D_EXPERT = 256
N_MOD = 6
RMS_EPS = 1e-6
NEG_INF = -1e30

kernel_name = 'hybrid_parallel_heads_diffusion_trunk'

F32 = jnp.float32


def rmsnorm(x, g):
    xf = x.astype(F32)
    y = xf * lax.rsqrt(jnp.mean(xf * xf, axis=-1, keepdims=True) + RMS_EPS)
    return (y * g.astype(F32)).astype(x.dtype)


def modulate(h, shift, scale):
    return h * (1 + scale) + shift


def to_heads(t):
    return t.reshape(t.shape[:-1] + (-1, HEAD_DIM))


def rope_axis(xa, pos):
    d = xa.shape[-1]
    inv = 1.0 / (ROPE_BASE ** (jnp.arange(0, d, 2, dtype=F32) / d))
    ang = pos.astype(F32)[:, None] * inv[None, :]
    cos = jnp.cos(ang)[:, None, :]
    sin = jnp.sin(ang)[:, None, :]
    x1, x2 = xa[..., : d // 2], xa[..., d // 2:]
    return jnp.concatenate([x1 * cos - x2 * sin, x2 * cos + x1 * sin], axis=-1)


def rope_2d(x, rows, cols):
    xf = x.astype(F32)
    half = x.shape[-1] // 2
    out = jnp.concatenate([rope_axis(xf[..., :half], rows), rope_axis(xf[..., half:], cols)], axis=-1)
    return out.astype(x.dtype)


def dense_attn(q, k, v, sink):
    b, l, hq, hd = q.shape
    hkv = k.shape[2]
    rep = hq // hkv
    qg = q.reshape(b, l, hkv, rep, hd)
    s = jnp.einsum('blgrd,bmgd->bgrlm', qg, k).astype(F32) * hd ** -0.5
    if sink is not None:
        sk = jnp.broadcast_to(sink.astype(F32).reshape(hkv, rep, 1, 1), (b, hkv, rep, l, 1))
        s = jnp.concatenate([s, sk], axis=-1)
    p = jax.nn.softmax(s, axis=-1)[..., : k.shape[1]]
    o = jnp.einsum('bgrlm,bmgd->blgrd', p.astype(v.dtype), v)
    return o.reshape(b, l, hq * hd)


def window_gqa(q, k, v, kc, vc, sink):
    b, s, hq, hd = q.shape
    nb = s // A_BLOCK
    rep = hq // A_KV_HEADS
    qb = q.reshape(b, nb, A_BLOCK, A_KV_HEADS, rep, hd)
    pad = ((0, 0), (A_BLOCK, A_BLOCK), (0, 0), (0, 0))
    kp = jnp.pad(k, pad).reshape(b, nb + 2, A_BLOCK, A_KV_HEADS, hd)
    vp = jnp.pad(v, pad).reshape(b, nb + 2, A_BLOCK, A_KV_HEADS, hd)
    kb = jnp.concatenate([kp[:, :-2], kp[:, 1:-1], kp[:, 2:]], axis=2)
    vb = jnp.concatenate([vp[:, :-2], vp[:, 1:-1], vp[:, 2:]], axis=2)
    scale = hd ** -0.5
    s_loc = jnp.einsum('bnqgrd,bnkgd->bngrqk', qb, kb).astype(F32) * scale
    qpos = jnp.arange(nb)[:, None] * A_BLOCK + jnp.arange(A_BLOCK)[None, :]
    kpos = jnp.arange(nb)[:, None] * A_BLOCK - A_BLOCK + jnp.arange(3 * A_BLOCK)[None, :]
    valid = ((jnp.abs(qpos[:, :, None] - kpos[:, None, :]) <= A_WINDOW)
             & (kpos >= 0)[:, None, :] & (kpos < s)[:, None, :])
    s_loc = jnp.where(valid[None, :, None, None], s_loc, NEG_INF)
    s_ctx = jnp.einsum('bnqgrd,blgd->bngrql', qb, kc).astype(F32) * scale
    s_sink = jnp.broadcast_to(sink.astype(F32).reshape(1, 1, A_KV_HEADS, rep, 1, 1),
                              (b, nb, A_KV_HEADS, rep, A_BLOCK, 1))
    p = jax.nn.softmax(jnp.concatenate([s_loc, s_ctx, s_sink], axis=-1), axis=-1)
    n_loc = 3 * A_BLOCK
    p_loc = p[..., :n_loc].astype(v.dtype)
    p_ctx = p[..., n_loc:n_loc + kc.shape[1]].astype(v.dtype)
    o = (jnp.einsum('bngrqk,bnkgd->bnqgrd', p_loc, vb)
         + jnp.einsum('bngrql,blgd->bnqgrd', p_ctx, vc))
    return o.reshape(b, s, hq * hd)


def neighborhood_attn(q, k, v, kc, vc, rpb):
    b, s, h, hd = q.shape
    rows = s // GRID_W
    kh = min(NA_WIN_ROWS, rows)
    kw = NA_WIN_COLS
    r = jnp.arange(rows)
    rs = jnp.clip(r - kh // 2, 0, rows - kh)
    row_idx = rs[:, None] + jnp.arange(kh)[None, :]
    cq = jnp.arange(GRID_W)
    cs = jnp.clip(cq - kw // 2, 0, GRID_W - kw)
    kcol = jnp.arange(GRID_W)
    col_valid = (kcol[None, :] >= cs[:, None]) & (kcol[None, :] < cs[:, None] + kw)
    qg = q.reshape(b, rows, GRID_W, h, hd)
    kg = k.reshape(b, rows, GRID_W, h, hd)[:, row_idx]
    vg = v.reshape(b, rows, GRID_W, h, hd)[:, row_idx]
    scale = hd ** -0.5
    sc = jnp.einsum('brchd,brikhd->brhcik', qg, kg).astype(F32) * scale
    roff = row_idx - r[:, None] + (NA_WIN_ROWS - 1)
    coff = jnp.clip(kcol[None, :] - cq[:, None], -(kw - 1), kw - 1) + (kw - 1)
    bias = rpb.astype(F32)[:, roff[:, None, :, None], coff[None, :, None, :]]
    sc = sc + jnp.transpose(bias, (1, 0, 2, 3, 4))[None]
    sc = jnp.where(col_valid[None, None, None, :, None, :], sc, NEG_INF)
    sc = sc.reshape(b, rows, h, GRID_W, kh * GRID_W)
    s_ctx = jnp.einsum('brchd,blhd->brhcl', qg, kc).astype(F32) * scale
    p = jax.nn.softmax(jnp.concatenate([sc, s_ctx], axis=-1), axis=-1)
    n_loc = kh * GRID_W
    p_loc = p[..., :n_loc].reshape(b, rows, h, GRID_W, kh, GRID_W).astype(v.dtype)
    p_ctx = p[..., n_loc:].astype(v.dtype)
    o = (jnp.einsum('brhcik,brikhd->brchd', p_loc, vg)
         + jnp.einsum('brhcl,blhd->brchd', p_ctx, vc))
    return o.reshape(b, s, h * hd)


def conv_centred(x, w, bias):
    kk, ch = w.shape
    y = lax.conv_general_dilated(x, w.astype(x.dtype).reshape(kk, 1, ch), window_strides=(1,),
                                 padding=[(kk // 2, kk // 2)],
                                 dimension_numbers=('NWC', 'WIO', 'NWC'), feature_group_count=ch)
    return y + bias


def ssd_scan(x, dt, a, bm, cm, init_state, with_output):
    b, l, h, p = x.shape
    n = bm.shape[-1]
    nc = l // SSD_CHUNK
    q = SSD_CHUNK
    xdt = (x.astype(F32) * dt[..., None]).reshape(b, nc, q, h, p)
    bc = bm.astype(F32).reshape(b, nc, q, h, n)
    cc = cm.astype(F32).reshape(b, nc, q, h, n)
    acs = jnp.cumsum((dt * a).reshape(b, nc, q, h), axis=2)
    total = acs[:, :, -1]
    decay_to_end = jnp.exp(total[:, :, None, :] - acs)
    states = jnp.einsum('bcqhn,bcqh,bcqhp->bchpn', bc, decay_to_end, xdt)

    def step(carry, inp):
        st, tot = inp
        return carry * jnp.exp(tot)[:, :, None, None] + st, carry

    final, prev = lax.scan(step, init_state,
                           (jnp.transpose(states, (1, 0, 2, 3, 4)), jnp.transpose(total, (1, 0, 2))))
    if not with_output:
        return None, final
    prev = jnp.transpose(prev, (1, 0, 2, 3, 4))
    y_off = jnp.einsum('bcqhn,bchpn->bcqhp', cc, prev) * jnp.exp(acs)[..., None]
    seg = acs[:, :, :, None, :] - acs[:, :, None, :, :]
    lower = jnp.tril(jnp.ones((q, q), dtype=bool))
    lmat = jnp.exp(jnp.where(lower[None, None, :, :, None], seg, NEG_INF))
    scores = jnp.einsum('bcihn,bcjhn->bcijh', cc, bc) * lmat
    y_diag = jnp.einsum('bcijh,bcjhp->bcihp', scores, xdt)
    return (y_diag + y_off).reshape(b, l, h, p), final


def ssd_branch(u, conv_w, conv_b, dt_bias, a_log, d_skip, norm_g, init_f, init_b, with_output):
    b, l, _ = u.shape
    z, xbc, dt_raw = jnp.split(u, [SSD_INNER, SSD_INNER + SSD_CONV_DIM], axis=-1)
    xbc = jax.nn.silu(conv_centred(xbc, conv_w, conv_b))
    xs, bm, cm = jnp.split(xbc, [SSD_INNER, SSD_INNER + SSD_GROUPS * SSD_STATE], axis=-1)
    xs = xs.reshape(b, l, SSD_HEADS, SSD_HEAD_DIM)
    rep = SSD_HEADS // SSD_GROUPS
    bm = jnp.repeat(bm.reshape(b, l, SSD_GROUPS, SSD_STATE), rep, axis=2)
    cm = jnp.repeat(cm.reshape(b, l, SSD_GROUPS, SSD_STATE), rep, axis=2)
    dt = jax.nn.softplus(dt_raw.astype(F32).reshape(b, l, 2, SSD_HEADS) + dt_bias.astype(F32))
    a = -jnp.exp(a_log.astype(F32))
    if init_f is None:
        init_f = jnp.zeros((b, SSD_HEADS, SSD_HEAD_DIM, SSD_STATE), F32)
        init_b = jnp.zeros((b, SSD_HEADS, SSD_HEAD_DIM, SSD_STATE), F32)
    flip = lambda t: jnp.flip(t, axis=1)
    y_f, st_f = ssd_scan(xs, dt[:, :, 0], a[0], bm, cm, init_f, with_output)
    y_b, st_b = ssd_scan(flip(xs), flip(dt[:, :, 1]), a[1], flip(bm), flip(cm), init_b, with_output)
    if not with_output:
        return None, st_f, st_b
    y = y_f + flip(y_b) + d_skip.astype(F32)[:, None] * xs.astype(F32)
    y = y.reshape(b, l, SSD_INNER) * jax.nn.silu(z.astype(F32))
    return rmsnorm(y, norm_g).astype(u.dtype), st_f, st_b


def token_mixers(ux, uc, rows_pos, cols_pos, sink, conv_w, conv_b, dt_bias, a_log, d_skip,
                 norm_g, rpb, need_ctx):
    ax, bx, nx = jnp.split(ux, [A_IN, A_IN + SSD_IN], axis=-1)
    ac, bcx, nc = jnp.split(uc, [A_IN, A_IN + SSD_IN], axis=-1)
    a_split = [A_WIDTH, A_WIDTH + A_KV_HEADS * HEAD_DIM]
    qa, ka, va = [to_heads(t) for t in jnp.split(ax, a_split, axis=-1)]
    qa_c, ka_c, va_c = [to_heads(t) for t in jnp.split(ac, a_split, axis=-1)]
    qa = rope_2d(qa, rows_pos, cols_pos)
    ka = rope_2d(ka, rows_pos, cols_pos)
    oa = window_gqa(qa, ka, va, ka_c, va_c, sink)
    ob_c, st_f, st_b = ssd_branch(bcx, conv_w, conv_b, dt_bias, a_log, d_skip, norm_g, None, None, need_ctx)
    ob, _, _ = ssd_branch(bx, conv_w, conv_b, dt_bias, a_log, d_skip, norm_g, st_f, st_b, True)
    n_split = [NA_WIDTH, 2 * NA_WIDTH]
    qn, kn, vn = [to_heads(t) for t in jnp.split(nx, n_split, axis=-1)]
    qn_c, kn_c, vn_c = [to_heads(t) for t in jnp.split(nc, n_split, axis=-1)]
    on = neighborhood_attn(qn, kn, vn, kn_c, vn_c, rpb)
    o_x = jnp.concatenate([oa, ob, on], axis=-1)
    if not need_ctx:
        return o_x, None
    oa_c = dense_attn(qa_c, ka_c, va_c, sink)
    on_c = dense_attn(qn_c, kn_c, vn_c, None)
    o_c = jnp.concatenate([oa_c, ob_c, on_c], axis=-1)
    return o_x, o_c


def hier_moe(h, w_rg, b_rg, w_re, b_re, w_gate, w_up, w_down):
    n = h.shape[0]
    g_prob = jax.nn.softmax((h @ w_rg).astype(F32) + b_rg.astype(F32), axis=-1)
    g_w, g_idx = lax.top_k(g_prob, 1)
    e_logits = ((h @ w_re).astype(F32) + b_re.astype(F32)).reshape(n, MOE_GROUPS, MOE_EXPERTS)
    e_logits = jnp.take_along_axis(e_logits, g_idx[:, :, None], axis=1)[:, 0]
    top_l, top_i = lax.top_k(e_logits, MOE_TOPK)
    top_w = jax.nn.softmax(top_l, axis=-1) * g_w
    comb = jnp.einsum('nk,nke->ne', top_w, jax.nn.one_hot(top_i, MOE_EXPERTS, dtype=F32))
    out = jnp.zeros((n, h.shape[1]), F32)
    for gi in range(MOE_GROUPS):
        wsel = jnp.where(g_idx == gi, comb, 0.0)
        hid = (jax.nn.silu(jnp.einsum('nd,edf->nef', h, w_gate[gi]))
               * jnp.einsum('nd,edf->nef', h, w_up[gi]))
        out = out + jnp.einsum('nef,efd->nd', hid * wsel[..., None].astype(hid.dtype), w_down[gi])
    return out.astype(h.dtype)


def setup_inputs(seed: int = 0) -> dict:
    key = jax.random.key(seed)
    ks = jax.random.split(key, 28)

    def nrm(k, shape, scale):
        return jax.random.normal(k, shape, F32) * scale

    x = nrm(ks[0], (BATCH, SEQ, D_MODEL), 1.0)
    c = nrm(ks[1], (BATCH, D_MODEL), 1.0)
    ctx = nrm(ks[2], (BATCH, CTX_LEN, D_MODEL), 1.0)
    c_ctx = nrm(ks[3], (D_MODEL,), 1.0)
    w_mod = nrm(ks[4], (DEPTH, D_MODEL, N_MOD * D_MODEL), 0.5 * D_MODEL ** -0.5)
    b_mod = nrm(ks[5], (DEPTH, N_MOD * D_MODEL), 0.02)
    g_mix = 1.0 + nrm(ks[6], (DEPTH, D_MODEL), 0.02)
    w_in = nrm(ks[7], (DEPTH, D_MODEL, N_IN), D_MODEL ** -0.5)
    attn_sink = nrm(ks[8], (DEPTH, A_HEADS), 0.5)
    ssd_conv_w = nrm(ks[9], (DEPTH, SSD_CONV, SSD_CONV_DIM), SSD_CONV ** -0.5)
    ssd_conv_b = nrm(ks[10], (DEPTH, SSD_CONV_DIM), 0.02)
    dt0 = jnp.exp(jax.random.uniform(ks[11], (DEPTH, 2, SSD_HEADS), F32, math.log(1e-3), math.log(1e-1)))
    ssd_dt_bias = dt0 + jnp.log(-jnp.expm1(-dt0))
    ssd_a_log = jnp.log(jax.random.uniform(ks[12], (DEPTH, 2, SSD_HEADS), F32, 1.0, 16.0))
    ssd_d = 1.0 + nrm(ks[13], (DEPTH, SSD_HEADS), 0.02)
    ssd_norm_g = 1.0 + nrm(ks[14], (DEPTH, SSD_INNER), 0.02)
    na_rpb = nrm(ks[15], (DEPTH, NA_HEADS, 2 * NA_WIN_ROWS - 1, 2 * NA_WIN_COLS - 1), 0.1)
    w_out = nrm(ks[16], (DEPTH, D_MIX, D_MODEL), D_MIX ** -0.5)
    g_ffn = 1.0 + nrm(ks[17], (DEPTH, D_MODEL), 0.02)
    w_router_group = nrm(ks[18], (DEPTH, D_MODEL, MOE_GROUPS), D_MODEL ** -0.5)
    b_router_group = nrm(ks[19], (DEPTH, MOE_GROUPS), 0.01)
    w_router_expert = nrm(ks[20], (DEPTH, D_MODEL, MOE_GROUPS * MOE_EXPERTS), D_MODEL ** -0.5)
    b_router_expert = nrm(ks[21], (DEPTH, MOE_GROUPS * MOE_EXPERTS), 0.01)
    w_exp_gate = nrm(ks[22], (DEPTH, MOE_GROUPS, MOE_EXPERTS, D_MODEL, D_EXPERT), D_MODEL ** -0.5)
    w_exp_up = nrm(ks[23], (DEPTH, MOE_GROUPS, MOE_EXPERTS, D_MODEL, D_EXPERT), D_MODEL ** -0.5)
    w_exp_down = nrm(ks[24], (DEPTH, MOE_GROUPS, MOE_EXPERTS, D_EXPERT, D_MODEL), D_EXPERT ** -0.5)
    g_final = 1.0 + nrm(ks[25], (D_MODEL,), 0.02)
    return {'x': x, 'c': c, 'ctx': ctx, 'c_ctx': c_ctx, 'w_mod': w_mod, 'b_mod': b_mod,
            'g_mix': g_mix, 'w_in': w_in, 'attn_sink': attn_sink, 'ssd_conv_w': ssd_conv_w,
            'ssd_conv_b': ssd_conv_b, 'ssd_dt_bias': ssd_dt_bias, 'ssd_a_log': ssd_a_log,
            'ssd_d': ssd_d, 'ssd_norm_g': ssd_norm_g, 'na_rpb': na_rpb, 'w_out': w_out,
            'g_ffn': g_ffn, 'w_router_group': w_router_group, 'b_router_group': b_router_group,
            'w_router_expert': w_router_expert, 'b_router_expert': b_router_expert,
            'w_exp_gate': w_exp_gate, 'w_exp_up': w_exp_up, 'w_exp_down': w_exp_down,
            'g_final': g_final}


def reference(x, c, ctx, c_ctx, w_mod, b_mod, g_mix, w_in, attn_sink, ssd_conv_w, ssd_conv_b,
              ssd_dt_bias, ssd_a_log, ssd_d, ssd_norm_g, na_rpb, w_out, g_ffn, w_router_group,
              b_router_group, w_router_expert, b_router_expert, w_exp_gate, w_exp_up, w_exp_down,
              g_final):
    b, s, d = x.shape
    l_ctx = ctx.shape[1]
    t = jnp.arange(s)
    rows_pos = t // GRID_W
    cols_pos = t % GRID_W
    mod_x_in = jax.nn.silu(c)
    mod_c_in = jax.nn.silu(c_ctx)
    for layer in range(DEPTH):
        need_ctx = layer < DEPTH - 1
        mx = (mod_x_in @ w_mod[layer] + b_mod[layer]).reshape(b, N_MOD, 1, d)
        mc = (mod_c_in @ w_mod[layer] + b_mod[layer]).reshape(N_MOD, d)
        hx = modulate(rmsnorm(x, g_mix[layer]), mx[:, 0], mx[:, 1])
        hc = modulate(rmsnorm(ctx, g_mix[layer]), mc[0], mc[1])
        ux = hx @ w_in[layer]
        uc = hc @ w_in[layer]
        o_x, o_c = token_mixers(ux, uc, rows_pos, cols_pos, attn_sink[layer], ssd_conv_w[layer],
                                ssd_conv_b[layer], ssd_dt_bias[layer], ssd_a_log[layer], ssd_d[layer],
                                ssd_norm_g[layer], na_rpb[layer], need_ctx)
        x = x + mx[:, 2] * (o_x @ w_out[layer])
        tokens = modulate(rmsnorm(x, g_ffn[layer]), mx[:, 3], mx[:, 4]).reshape(b * s, d)
        if need_ctx:
            ctx = ctx + mc[2] * (o_c @ w_out[layer])
            h2c = modulate(rmsnorm(ctx, g_ffn[layer]), mc[3], mc[4]).reshape(b * l_ctx, d)
            tokens = jnp.concatenate([tokens, h2c], axis=0)
        f = hier_moe(tokens, w_router_group[layer], b_router_group[layer], w_router_expert[layer],
                     b_router_expert[layer], w_exp_gate[layer], w_exp_up[layer], w_exp_down[layer])
        x = x + mx[:, 5] * f[: b * s].reshape(b, s, d)
        if need_ctx:
            ctx = ctx + mc[5] * f[b * s:].reshape(b, l_ctx, d)
    return rmsnorm(x, g_final)
```

```cpp
#include <hip/hip_runtime.h>
#include <cstdio>
#include <cstdint>
#ifndef GHD
#ifdef __HIPCC__
#define GHD __host__ __device__ __forceinline__
#else
#define GHD inline
#endif
#endif
#include <math.h>

template <int D_MODEL_, int BATCH_, int SEQ_, int DEPTH_, int CTX_, int DEXP_>
struct GDims {
    static constexpr int D = D_MODEL_, B = BATCH_, S = SEQ_, DEPTH = DEPTH_, L = CTX_, DE = DEXP_;
    static constexpr int GW = 64, HD = 64;
    static constexpr int NLAT = B * S, NCTX = B * L, NT = NLAT + NCTX;
    static constexpr int A_IN = 512, SSD_IN = 1296, NA_IN = 768, N_IN = 2576, D_MIX = 1024;
    static constexpr int U_Z = 512, U_XBC = 1024, U_DT = 1792, U_NA = 1808;
    static constexpr int ROWS = S / GW;
    static constexpr int KH = ROWS < 8 ? ROWS : 8;
};

struct GPtrs {
    const float *x, *c, *ctx, *c_ctx, *w_mod, *b_mod, *g_mix, *w_in, *sink, *conv_w, *conv_b, *dt_bias, *a_log, *ssd_d, *ssd_g, *rpb,
        *w_out, *g_ffn, *w_rg, *b_rg, *w_re, *b_re, *w_eg, *w_eu, *w_ed, *g_final;
    float *mods;
    float *xg;
    float *rs;
    float *h;
    float *u;
    float *xc;
    float *dtv;
    float *yf, *yb;
    float *yg;
    float *o;
    float *logit;
    int   *sel;
    float *selw;
    float *hid;
    float *out;
};

GHD float g_silu(float x) { return x / (1.0f + expf(-x)); }
GHD float g_softplus(float x) { return x > 20.f ? x : log1pf(expf(x)); }

template <class C> GHD void g_rowinfo(int row, int& isctx, int& b, int& t) {
    if (row < C::NLAT) { isctx = 0; b = row / C::S; t = row % C::S; } else { int r = row - C::NLAT; isctx = 1; b = r / C::L; t = r % C::L; }
}
template <class C> GHD int g_modb(int row) { return row < C::NLAT ? row / C::S : C::B; }

template <class C> GHD void st_mod(const GPtrs& p, long idx) {
    const int N6 = 6 * C::D; int n = idx % N6; int bb = (idx / N6) % (C::B + 1); int l = idx / ((long)(C::B + 1) * N6);
    const float* cv = bb < C::B ? p.c + (long)bb * C::D : p.c_ctx;
    const float* w = p.w_mod + (long)l * C::D * N6;
    float acc = 0.f;
    for (int k = 0; k < C::D; ++k) acc += g_silu(cv[k]) * w[(long)k * N6 + n];
    p.mods[idx] = acc + p.b_mod[(long)l * N6 + n];
}
template <class C> GHD const float* g_mod(const GPtrs& p, int l, int row, int j) { return p.mods + ((long)(l * (C::B + 1) + g_modb<C>(row)) * 6 + j) * C::D; }

template <class C> GHD void st_init(const GPtrs& p, long idx) {
    long r = idx / C::D; p.xg[idx] = r < C::NLAT ? p.x[idx] : p.ctx[idx - (long)C::NLAT * C::D];
}
template <class C> GHD void st_rstd(const GPtrs& p, long row) {
    const float* xr = p.xg + row * C::D; float s = 0.f;
    for (int k = 0; k < C::D; ++k) s += xr[k] * xr[k];
    p.rs[row] = 1.0f / sqrtf(s / C::D + 1e-6f);
}
template <class C> GHD void st_hnorm(const GPtrs& p, long idx, int l, const float* g, int js, int jc) {
    int row = idx / C::D, k = idx % C::D;
    float v = p.xg[idx] * p.rs[row] * g[(long)l * C::D + k];
    p.h[idx] = v * (1.f + g_mod<C>(p, l, row, jc)[k]) + g_mod<C>(p, l, row, js)[k];
}
template <class C> GHD void st_u(const GPtrs& p, long idx, int l) {
    int row = idx / C::N_IN, n = idx % C::N_IN;
    const float* hr = p.h + (long)row * C::D; const float* w = p.w_in + (long)l * C::D * C::N_IN + n;
    float acc = 0.f;
    for (int k = 0; k < C::D; ++k) acc += hr[k] * w[(long)k * C::N_IN];
    p.u[idx] = acc;
}
template <class C> GHD void st_rope(const GPtrs& p, long idx) {
    int i = idx % 32; int hh = (idx / 32) % 6; int row = idx / (32 * 6);
    int t = row % C::S; int pos = (i < 16) ? (t / C::GW) : (t % C::GW);
    int fi = i & 15; int base = hh * 64 + (i < 16 ? 0 : 32);
    float inv = 1.0f / powf(10000.0f, (float)(2 * fi) / 32.0f);
    float ang = (float)pos * inv; float cs = cosf(ang), sn = sinf(ang);
    float* ur = p.u + (long)row * C::N_IN + base;
    float x1 = ur[fi], x2 = ur[fi + 16];
    ur[fi] = x1 * cs - x2 * sn; ur[fi + 16] = x2 * cs + x1 * sn;
}
struct GAttn { float m, l; float o[64]; };
GHD void ga_init(GAttn& a) { a.m = -3.0e38f; a.l = 0.f;
#pragma unroll
    for (int d = 0; d < 64; ++d) a.o[d] = 0.f; }
GHD void ga_key(GAttn& a, const float (&q)[64], const float* k, const float* v, float bias) {
    float s = 0.f;
#pragma unroll
    for (int d = 0; d < 64; ++d) s += q[d] * k[d];
    s = s * 0.125f + bias;
    float mn = s > a.m ? s : a.m; float sc = expf(a.m - mn), pe = expf(s - mn);
    a.l = a.l * sc + pe;
#pragma unroll
    for (int d = 0; d < 64; ++d) a.o[d] = a.o[d] * sc + pe * v[d];
    a.m = mn;
}
GHD void ga_sink(GAttn& a, float s) { float mn = s > a.m ? s : a.m; float sc = expf(a.m - mn), pe = expf(s - mn); a.l = a.l * sc + pe;
#pragma unroll
    for (int d = 0; d < 64; ++d) a.o[d] *= sc;
    a.m = mn; }
template <class C> GHD void st_attnA(const GPtrs& p, long idx, int l) {
    int qh = idx % 4; int row = idx / 4; int b = row / C::S, t = row % C::S; int g = qh / 2;
    float q[64]; const float* ur = p.u + (long)row * C::N_IN + qh * 64;
#pragma unroll
    for (int d = 0; d < 64; ++d) q[d] = ur[d];
    GAttn a; ga_init(a);
    int k0 = t - 128 < 0 ? 0 : t - 128, k1 = t + 128 > C::S - 1 ? C::S - 1 : t + 128;
    for (int kp = k0; kp <= k1; ++kp) { const float* kr = p.u + (long)(b * C::S + kp) * C::N_IN; ga_key(a, q, kr + 256 + g * 64, kr + 384 + g * 64, 0.f); }
    for (int kp = 0; kp < C::L; ++kp) { const float* kr = p.u + (long)(C::NLAT + b * C::L + kp) * C::N_IN; ga_key(a, q, kr + 256 + g * 64, kr + 384 + g * 64, 0.f); }
    ga_sink(a, p.sink[l * 4 + qh]);
    float* orow = p.o + (long)row * 1024 + qh * 64; float il = 1.f / a.l;
#pragma unroll
    for (int d = 0; d < 64; ++d) orow[d] = a.o[d] * il;
}
template <class C> GHD void st_attnC(const GPtrs& p, long idx, int l) {
    int hh = idx % 8; int r = idx / 8; int b = r / C::L; int row = C::NLAT + r;
    int qoff, koff, voff, ooff; float sk = 0.f; bool has_sink = false;
    if (hh < 4) { int g = hh / 2; qoff = hh * 64; koff = 256 + g * 64; voff = 384 + g * 64; ooff = hh * 64; has_sink = true; sk = p.sink[l * 4 + hh]; }
    else { int h = hh - 4; qoff = C::U_NA + h * 64; koff = C::U_NA + 256 + h * 64; voff = C::U_NA + 512 + h * 64; ooff = 768 + h * 64; }
    float q[64]; const float* ur = p.u + (long)row * C::N_IN + qoff;
#pragma unroll
    for (int d = 0; d < 64; ++d) q[d] = ur[d];
    GAttn a; ga_init(a);
    for (int kp = 0; kp < C::L; ++kp) { const float* kr = p.u + (long)(C::NLAT + b * C::L + kp) * C::N_IN; ga_key(a, q, kr + koff, kr + voff, 0.f); }
    if (has_sink) ga_sink(a, sk);
    float* orow = p.o + (long)row * 1024 + ooff; float il = 1.f / a.l;
#pragma unroll
    for (int d = 0; d < 64; ++d) orow[d] = a.o[d] * il;
}
template <class C> GHD void st_attnN(const GPtrs& p, long idx, int l) {
    int h = idx % 4; int row = idx / 4; int b = row / C::S, t = row % C::S; int r = t / C::GW, c = t % C::GW;
    float q[64]; const float* ur = p.u + (long)row * C::N_IN + C::U_NA + h * 64;
#pragma unroll
    for (int d = 0; d < 64; ++d) q[d] = ur[d];
    GAttn a; ga_init(a);
    int rs0 = r - C::KH / 2; if (rs0 < 0) rs0 = 0; if (rs0 > C::ROWS - C::KH) rs0 = C::ROWS - C::KH;
    int cs0 = c - 8; if (cs0 < 0) cs0 = 0; if (cs0 > C::GW - 16) cs0 = C::GW - 16;
    for (int i = 0; i < C::KH; ++i) for (int j = 0; j < 16; ++j) {
        int kr_ = rs0 + i, kc_ = cs0 + j; int roff = kr_ - r + 7; int dc = kc_ - c; if (dc < -15) dc = -15; if (dc > 15) dc = 15; int coff = dc + 15;
        float bias = p.rpb[((long)(l * 4 + h) * 15 + roff) * 31 + coff];
        const float* kr = p.u + (long)(b * C::S + kr_ * C::GW + kc_) * C::N_IN + C::U_NA;
        ga_key(a, q, kr + 256 + h * 64, kr + 512 + h * 64, bias);
    }
    for (int kp = 0; kp < C::L; ++kp) { const float* kr = p.u + (long)(C::NLAT + b * C::L + kp) * C::N_IN + C::U_NA; ga_key(a, q, kr + 256 + h * 64, kr + 512 + h * 64, 0.f); }
    float* orow = p.o + (long)row * 1024 + 768 + h * 64; float il = 1.f / a.l;
#pragma unroll
    for (int d = 0; d < 64; ++d) orow[d] = a.o[d] * il;
}
template <class C> GHD void st_conv(const GPtrs& p, long idx, int l) {
    int ch = idx % 768; int row = idx / 768; int isctx, b, t; g_rowinfo<C>(row, isctx, b, t);
    int len = isctx ? C::L : C::S; long base = row - t;
    float acc = p.conv_b[l * 768 + ch];
#pragma unroll
    for (int j = 0; j < 5; ++j) { int tt = t + j - 2; if (tt >= 0 && tt < len) acc += p.u[(base + tt) * C::N_IN + C::U_XBC + ch] * p.conv_w[(l * 5 + j) * 768 + ch]; }
    p.xc[idx] = g_silu(acc);
}
template <class C> GHD void st_dt(const GPtrs& p, long idx, int l) {
    int j = idx % 16; int row = idx / 16;
    p.dtv[idx] = g_softplus(p.u[(long)row * C::N_IN + C::U_DT + j] + p.dt_bias[l * 16 + j]);
}
template <class C> GHD void st_scan(const GPtrs& p, long idx, int l) {
    int dir = idx % 2; int pp = (idx / 2) % 64; int h = (idx / 128) % 8; int b = idx / 1024; int g = h / 4;
    float a = -expf(p.a_log[l * 16 + dir * 8 + h]);
    float st[64];
#pragma unroll
    for (int n = 0; n < 64; ++n) st[n] = 0.f;
    float* yo = dir ? p.yb : p.yf;
    const int total = C::L + C::S;
    for (int i = 0; i < total; ++i) {
        long row;
        if (dir == 0) row = i < C::L ? (long)C::NLAT + b * C::L + i : (long)b * C::S + (i - C::L);
        else          row = i < C::L ? (long)C::NLAT + b * C::L + (C::L - 1 - i) : (long)b * C::S + (C::S - 1 - (i - C::L));
        float dt = p.dtv[row * 16 + dir * 8 + h]; float dec = expf(dt * a);
        const float* xr = p.xc + row * 768; float xv = xr[h * 64 + pp] * dt; const float* Bv = xr + 512 + g * 64; const float* Cv = xr + 640 + g * 64;
        float y = 0.f;
#pragma unroll
        for (int n = 0; n < 64; ++n) { st[n] = st[n] * dec + xv * Bv[n]; y += Cv[n] * st[n]; }
        yo[row * 512 + h * 64 + pp] = y;
    }
}
template <class C> GHD void st_gate(const GPtrs& p, long idx, int l) {
    int ch = idx % 512; long row = idx / 512; int h = ch / 64;
    float y = p.yf[idx] + p.yb[idx] + p.ssd_d[l * 8 + h] * p.xc[row * 768 + ch];
    p.yg[idx] = y * g_silu(p.u[row * C::N_IN + C::U_Z + ch]);
}
template <class C> GHD void st_ssdnorm(const GPtrs& p, long idx, int l) {
    int ch = idx % 512; long row = idx / 512; const float* yr = p.yg + row * 512; float s = 0.f;
    for (int k = 0; k < 512; ++k) s += yr[k] * yr[k];
    p.o[row * 1024 + 256 + ch] = yr[ch] / sqrtf(s / 512.f + 1e-6f) * p.ssd_g[l * 512 + ch];
}
template <class C> GHD void st_out(const GPtrs& p, long idx, int l, int need_ctx) {
    int d = idx % C::D; long row = idx / C::D; if (row >= C::NLAT && !need_ctx) return;
    const float* orow = p.o + row * 1024; const float* w = p.w_out + (long)l * 1024 * C::D + d; float acc = 0.f;
    for (int k = 0; k < 1024; ++k) acc += orow[k] * w[(long)k * C::D];
    p.xg[idx] += g_mod<C>(p, l, (int)row, 2)[d] * acc;
}
template <class C> GHD void st_logit(const GPtrs& p, long idx, int l) {
    int j = idx % 36; long row = idx / 36; const float* hr = p.h + row * C::D; float acc = 0.f;
    if (j < 4) { const float* w = p.w_rg + (long)l * C::D * 4 + j; for (int k = 0; k < C::D; ++k) acc += hr[k] * w[(long)k * 4]; acc += p.b_rg[l * 4 + j]; }
    else { int e = j - 4; const float* w = p.w_re + (long)l * C::D * 32 + e; for (int k = 0; k < C::D; ++k) acc += hr[k] * w[(long)k * 32]; acc += p.b_re[l * 32 + e]; }
    p.logit[idx] = acc;
}
template <class C> GHD void st_route(const GPtrs& p, long row) {
    const float* lg = p.logit + row * 36;
    int gi = 0; float gm = lg[0];
    for (int j = 1; j < 4; ++j) if (lg[j] > gm) { gm = lg[j]; gi = j; }
    float gs = 0.f; for (int j = 0; j < 4; ++j) gs += expf(lg[j] - gm);
    float gw = 1.f / gs;
    const float* el = lg + 4 + gi * 8;
    int i0 = 0; float v0 = el[0];
    for (int j = 1; j < 8; ++j) if (el[j] > v0) { v0 = el[j]; i0 = j; }
    int i1 = -1; float v1 = 0.f;
    for (int j = 0; j < 8; ++j) if (j != i0 && (i1 < 0 || el[j] > v1)) { v1 = el[j]; i1 = j; }
    float e1 = expf(v1 - v0); float w0 = 1.f / (1.f + e1), w1 = e1 / (1.f + e1);
    p.sel[row * 2] = gi * 8 + i0; p.sel[row * 2 + 1] = gi * 8 + i1; p.selw[row * 2] = w0 * gw; p.selw[row * 2 + 1] = w1 * gw;
}
template <class C> GHD void st_hidden(const GPtrs& p, long idx, int l, int need_ctx) {
    int f = idx % C::DE; int kk = (idx / C::DE) % 2; long row = idx / (2 * C::DE); if (row >= C::NLAT && !need_ctx) return;
    int e = p.sel[row * 2 + kk]; const float* hr = p.h + row * C::D;
    const float* wg = p.w_eg + ((long)(l * 32 + e) * C::D) * C::DE + f; const float* wu = p.w_eu + ((long)(l * 32 + e) * C::D) * C::DE + f;
    float ag = 0.f, au = 0.f;
    for (int k = 0; k < C::D; ++k) { float hv = hr[k]; ag += hv * wg[(long)k * C::DE]; au += hv * wu[(long)k * C::DE]; }
    p.hid[idx] = g_silu(ag) * au;
}
template <class C> GHD void st_down(const GPtrs& p, long idx, int l, int need_ctx) {
    int d = idx % C::D; long row = idx / C::D; if (row >= C::NLAT && !need_ctx) return;
    float acc = 0.f;
    for (int kk = 0; kk < 2; ++kk) { int e = p.sel[row * 2 + kk]; const float* hv = p.hid + (row * 2 + kk) * C::DE; const float* wd = p.w_ed + ((long)(l * 32 + e) * C::DE) * C::D + d;
        float a = 0.f; for (int f = 0; f < C::DE; ++f) a += hv[f] * wd[(long)f * C::D]; acc += p.selw[row * 2 + kk] * a; }
    p.xg[idx] += g_mod<C>(p, l, (int)row, 5)[d] * acc;
}
template <class C> GHD void st_final(const GPtrs& p, long idx) {
    int d = idx % C::D; long row = idx / C::D; p.out[idx] = p.xg[idx] * p.rs[row] * p.g_final[d];
}

#define GOLDEN_PROGRAM(C, p, RUN) do { \
    RUN((long)C::DEPTH * (C::B + 1) * 6 * C::D, st_mod<C>(p, idx)); \
    RUN((long)C::NT * C::D, st_init<C>(p, idx)); \
    for (int l = 0; l < C::DEPTH; ++l) { const int need_ctx = l < C::DEPTH - 1; \
        RUN((long)C::NT, st_rstd<C>(p, idx)); \
        RUN((long)C::NT * C::D, st_hnorm<C>(p, idx, l, p.g_mix, 0, 1)); \
        RUN((long)C::NT * C::N_IN, st_u<C>(p, idx, l)); \
        GOLDEN_HOOK(l, 0); \
        RUN((long)C::NLAT * 6 * 32, st_rope<C>(p, idx)); \
        RUN((long)C::NLAT * 4, st_attnA<C>(p, idx, l)); \
        RUN((long)C::NLAT * 4, st_attnN<C>(p, idx, l)); \
        if (need_ctx) RUN((long)C::NCTX * 8, st_attnC<C>(p, idx, l)); \
        RUN((long)C::NT * 768, st_conv<C>(p, idx, l)); \
        RUN((long)C::NT * 16, st_dt<C>(p, idx, l)); \
        RUN((long)C::B * 8 * 64 * 2, st_scan<C>(p, idx, l)); \
        RUN((long)C::NT * 512, st_gate<C>(p, idx, l)); \
        RUN((long)C::NT * 512, st_ssdnorm<C>(p, idx, l)); \
        GOLDEN_HOOK(l, 1); \
        RUN((long)C::NT * C::D, st_out<C>(p, idx, l, need_ctx)); \
        GOLDEN_HOOK(l, 2); \
        RUN((long)C::NT, st_rstd<C>(p, idx)); \
        RUN((long)C::NT * C::D, st_hnorm<C>(p, idx, l, p.g_ffn, 3, 4)); \
        RUN((long)C::NT * 36, st_logit<C>(p, idx, l)); \
        RUN((long)C::NT, st_route<C>(p, idx)); \
        RUN((long)C::NT * 2 * C::DE, st_hidden<C>(p, idx, l, need_ctx)); \
        RUN((long)C::NT * C::D, st_down<C>(p, idx, l, need_ctx)); \
        GOLDEN_HOOK(l, 3); \
    } \
    RUN((long)C::NLAT, st_rstd<C>(p, idx)); \
    RUN((long)C::NLAT * C::D, st_final<C>(p, idx)); \
} while (0)

typedef GDims<1024, 8, 2048, 4, 256, 256> CF;
template <class F> __global__ void __launch_bounds__(256) gk(F f, long n) {
    for (long idx = (long)blockIdx.x * blockDim.x + threadIdx.x; idx < n; idx += (long)gridDim.x * blockDim.x) f(idx);
}
#define GOLDEN_HOOK(l, w) do {} while (0)
struct GCtx { GPtrs p; int l; int need_ctx; };
static_assert(sizeof(GCtx) == sizeof(GPtrs) + 8 && sizeof(GPtrs) % 8 == 0, "GCtx must have no padding");
#define RUN(n, call) do { const long _n = (n); GCtx _cx; _cx.p = p; _cx.l = l; _cx.need_ctx = need_ctx; \
    auto _f = [_cx] __device__ (long idx) { const GPtrs& p = _cx.p; const int l = _cx.l; const int need_ctx = _cx.need_ctx; (void)l; (void)need_ctx; call; }; \
    const int _bs = _n <= 65536 ? 64 : 256; long _g = (_n + _bs - 1) / _bs; if (_g > 1048576) _g = 1048576; \
    hipLaunchKernelGGL(gk, dim3((unsigned)_g), dim3(_bs), 0, stream, _f, _n); } while (0)

extern "C" void kernel_launch(void* const* d_in, const int* in_sizes, int n_in, void* d_out, int out_size, void* d_ws, size_t ws_size, hipStream_t stream) {
    typedef CF C;
    GPtrs p{};
    const float** ip = (const float**)&p;
    for (int i = 0; i < 26; ++i) ip[i] = (const float*)d_in[i];
    char* w = (char*)d_ws; size_t off = 0;
    auto A = [&](size_t bytes) { char* r = w + off; off += (bytes + 255) & ~(size_t)255; return r; };
    p.mods = (float*)A((size_t)C::DEPTH * (C::B + 1) * 6 * C::D * 4);
    p.xg = (float*)A((size_t)C::NT * C::D * 4);
    p.rs = (float*)A((size_t)C::NT * 4);
    p.h = (float*)A((size_t)C::NT * C::D * 4);
    p.xc = p.h;
    p.u = (float*)A((size_t)C::NT * C::N_IN * 4);
    p.dtv = (float*)A((size_t)C::NT * 16 * 4);
    p.yf = (float*)A((size_t)C::NT * 512 * 4);
    p.yb = (float*)A((size_t)C::NT * 512 * 4);
    p.yg = p.yf;
    p.hid = p.yb;
    p.o = (float*)A((size_t)C::NT * 1024 * 4);
    p.logit = (float*)A((size_t)C::NT * 36 * 4);
    p.sel = (int*)A((size_t)C::NT * 2 * 4);
    p.selw = (float*)A((size_t)C::NT * 2 * 4);
    p.out = (float*)d_out;
    if (off > ws_size) { fprintf(stderr, "workspace too small: need %zu have %zu\n", off, ws_size); return; }
    int l = 0, need_ctx = 0;
    GOLDEN_PROGRAM(C, p, RUN);
}
```

```cpp
#include <hip/hip_runtime.h>
#include <cstdio>
#include <cstdint>
#include <math.h>
#define XB_TMO      128
#define XB_XCNT(j)  (256  + 64 * (j))
#define XB_XSUB(j)  (1280 + 64 * (j))
#define XB_XGEN(j)  (2304 + 64 * (j))
#define XB_TOP      3328
#define XB_TOPGEN   3392
#define XCD_BAR_WORDS 3456
#define XB_SPIN_CAP (1u << 18)
#define LAS __attribute__((address_space(3)))

__device__ __forceinline__ unsigned xb_ld(unsigned* p)              { return __hip_atomic_load(p, __ATOMIC_RELAXED, __HIP_MEMORY_SCOPE_AGENT); }
__device__ __forceinline__ unsigned xb_add(unsigned* p, unsigned v) { return __hip_atomic_fetch_add(p, v, __ATOMIC_RELAXED, __HIP_MEMORY_SCOPE_AGENT); }
__device__ __forceinline__ unsigned xb_xcc_id() { return (unsigned)__builtin_amdgcn_s_getreg((3 << 11) | 20) & 0xFu; }
#define XB_SPIN(cond, bar) do { unsigned _sp = 0; while (cond) { __builtin_amdgcn_s_sleep(1); \
    if ((++_sp & 255u) == 0u) { if (xb_ld(&(bar)[XB_TMO])) break; if (_sp > XB_SPIN_CAP) { atomicAdd(&(bar)[XB_TMO], 1u); break; } } } } while (0)

struct XcdBarrier {
    unsigned* bar; unsigned x;
    volatile LAS unsigned* st;
};

__device__ __forceinline__ XcdBarrier xcd_barrier_post(unsigned* bar, volatile LAS unsigned* st) {
    XcdBarrier b; b.bar = bar; b.x = xb_xcc_id(); b.st = st;
    if (threadIdx.x == 0) (void)xb_add(&bar[XB_XCNT(b.x)], 1u);
    return b;
}
__device__ __forceinline__ void xcd_barrier_complete(unsigned* bar, unsigned x, unsigned& nloc, unsigned& nx) {
    const unsigned G = gridDim.x * gridDim.y * gridDim.z;
    unsigned sum, cnt, mine, sp = 0u;
    for (;;) {
        sum = 0u; cnt = 0u; mine = 0u;
#pragma unroll
        for (unsigned j = 0; j < 16; ++j) { const unsigned c = xb_ld(&bar[XB_XCNT(j)]); sum += c; cnt += (c > 0u) ? 1u : 0u; mine = (j == x) ? c : mine; }
        if (sum == G) break;
        __builtin_amdgcn_s_sleep(1);
        if ((++sp & 255u) == 0u) { if (xb_ld(&bar[XB_TMO])) break; if (sp > XB_SPIN_CAP) { atomicAdd(&bar[XB_TMO], 1u); break; } }
    }
    nloc = mine > 0u ? mine : 1u; nx = cnt > 0u ? cnt : 1u;
}

__device__ __forceinline__ void xcd_barrier(const XcdBarrier& b) {
    asm volatile("s_waitcnt vmcnt(0)" ::: "memory");
    __syncthreads();
    if (threadIdx.x == 0) {
        unsigned* bar = b.bar;
        __builtin_amdgcn_s_waitcnt(0);
        unsigned nloc = b.st[0], nx = b.st[1];
        if (nloc == 0u) { xcd_barrier_complete(bar, b.x, nloc, nx); b.st[0] = nloc; b.st[1] = nx; }
        const unsigned old = xb_add(&bar[XB_XSUB(b.x)], 1u);
        const unsigned gen = old / nloc;
        if (old + 1u == (gen + 1u) * nloc) {
            __builtin_amdgcn_fence(__ATOMIC_RELEASE, "agent");
            asm volatile("s_waitcnt vmcnt(0)" ::: "memory");
            const unsigned og = xb_add(&bar[XB_TOP], 1u);
            const unsigned tg = og / nx;
            if (og + 1u == (tg + 1u) * nx) xb_add(&bar[XB_TOPGEN], 1u);
            else XB_SPIN(xb_ld(&bar[XB_TOPGEN]) == tg, bar);
            __builtin_amdgcn_fence(__ATOMIC_ACQUIRE, "agent");
            xb_add(&bar[XB_XGEN(b.x)], 1u);
            asm volatile("s_waitcnt vmcnt(0)" ::: "memory");
        } else {
            XB_SPIN(xb_ld(&bar[XB_XGEN(b.x)]) == gen, bar);
            __builtin_amdgcn_fence(__ATOMIC_ACQUIRE, "agent");
            asm volatile("s_waitcnt vmcnt(0)" ::: "memory");
        }
    }
    __syncthreads();
}

namespace pg8 {
#define PG8_LAS __attribute__((address_space(3)))
typedef unsigned short bf16_t;
typedef short bf16x8 __attribute__((ext_vector_type(8)));
typedef float f32x4 __attribute__((ext_vector_type(4)));
typedef unsigned u32x4 __attribute__((ext_vector_type(4)));
constexpr int BM = 256, BK = 64, HALF = 128, HTB = HALF * BK * 2  , STAGE_BYTES = 8 * HTB, NXCD = 8, WGM = 8;

__host__ __device__ __forceinline__ int lds_byte(int r, int c) { const int st = (r >> 4) * 2 + (c >> 5), rr = r & 15, cc = c & 31, ob = rr * 64 + cc * 2; return st * 1024 + (ob ^ (((ob >> 9) & 1) << 5)); }
__host__ __device__ __forceinline__ void stage_rc(int b, int& R, int& C) { const int st = b / 1024, sb = b % 1024, swz = sb ^ (((sb >> 9) & 1) << 5); R = (st >> 1) * 16 + swz / 64; C = (st & 1) * 32 + (swz % 64) / 2; }
__host__ __device__ __forceinline__ int perm32(int rho) { const int n = rho >> 4, i = rho & 15; return 8 * (i >> 2) + 4 * n + (i & 3); }

struct Unit { int pm, pn; };
struct Gemm { const bf16_t* A; const bf16_t* Bt; int M, N, K; };

struct StaticOrder {
    int nM, nN, nwg, G, c;
    __host__ __device__ void init(int M, int N, int G_, int c_) { nM = M / BM; nN = N / BM; nwg = nM * nN; G = G_; c = c_; }
    __host__ __device__ bool next(int i, Unit& u) const {
        const long L = (long)i * G + c; if (L >= nwg) return false;
        int wgid = (int)L; { const int q = nwg / NXCD, r = nwg % NXCD, xcd = wgid % NXCD, off = wgid / NXCD; wgid = (xcd < r ? xcd * (q + 1) : r * (q + 1) + (xcd - r) * q) + off; }
        const int nig = WGM * nN, gid = wgid / nig, fm = gid * WGM, gsz = (nM - fm) < WGM ? (nM - fm) : WGM;
        u.pm = fm + ((wgid % nig) % gsz); u.pn = (wgid % nig) / gsz; return true;
    }
    __device__ __forceinline__ void a_ready(const Unit&) const {}
    __device__ __forceinline__ void done(const Unit&) const {}
};
__device__ __forceinline__ unsigned cvt_pk_bf16(float lo, float hi) { unsigned r; asm volatile("v_cvt_pk_bf16_f32 %0, %1, %2" : "=v"(r) : "v"(lo), "v"(hi)); return r; }
typedef float f32x2 __attribute__((ext_vector_type(2)));
template <class Epi, class Sched, bool STAMP = false>
__device__ __forceinline__ void gemm_phase(PG8_LAS unsigned char* lds, const Gemm g, const Sched& S, const Epi& E, unsigned long long* stamps, const int wid  ) {
    int lane_; asm volatile("v_mbcnt_lo_u32_b32 %0, -1, 0\n\tv_mbcnt_hi_u32_b32 %0, -1, %0" : "=v"(lane_));
    const int lane = lane_, tid = wid * 64 + lane, wr = wid >> 2, wc = wid & 3, fr = lane & 15, fq = lane >> 4;
    const int K = g.K, nt = K / BK;
    int ts_lo = 0, ts_hi = 0, nts = 0; const unsigned long long rt_entry = STAMP ? (unsigned long long)wall_clock64() : 0ull;
#define PG8_STAMP() do { if (STAMP && wid == 0 && nts < 64) { const unsigned long long _c = (unsigned long long)clock64(); \
        ts_lo = (lane == nts) ? (int)(unsigned)_c : ts_lo; ts_hi = (lane == nts) ? (int)(unsigned)(_c >> 32) : ts_hi; ++nts; } } while (0)
    PG8_STAMP();
    unsigned voffA[2], voffB[2];
#pragma unroll
    for (int i = 0; i < 2; ++i) { int R, C; stage_rc(tid * 16 + i * 8192, R, C); const int Rb = Epi::PERM ? ((R & ~31) + perm32(R & 31)) : R;
        voffA[i] = (unsigned)(R * K + C) * 2u; voffB[i] = (unsigned)(Rb * K + C) * 2u; }
    const size_t kstep = (size_t)(BK * 2);
    const size_t hstep = (size_t)HALF * K * 2;
    const size_t tstep = 2 * hstep;
    const unsigned ldsw = (unsigned)wid * 1024u;
    const int aoff = lds_byte(wr * 64 + fr, fq * 8), boff = lds_byte(wc * 32 + fr, fq * 8);
#define PG8_SA(b, h) (((b) * 2 + (h)) * HTB)
#define PG8_SB(b, h) ((4 + (b) * 2 + (h)) * HTB)
#define PG8_STAGE(bufoff, gbase, voff) do { _Pragma("unroll") for (int _i = 0; _i < 2; ++_i) \
        __builtin_amdgcn_global_load_lds((const unsigned*)((const char*)(gbase) + (voff)[_i]), (PG8_LAS unsigned*)(lds + (bufoff) + ldsw + _i * 8192), 16, 0, 0); } while (0)
#define PG8_LDA(dst, b, h) do { _Pragma("unroll") for (int m = 0; m < 4; ++m) _Pragma("unroll") for (int k = 0; k < 2; ++k) dst[m][k] = *(const PG8_LAS bf16x8*)(lds + PG8_SA(b, h) + aoff + m * 2048 + k * 1024); } while (0)
#define PG8_LDB(dst, b, h) do { _Pragma("unroll") for (int n = 0; n < 2; ++n) _Pragma("unroll") for (int k = 0; k < 2; ++k) dst[n][k] = *(const PG8_LAS bf16x8*)(lds + PG8_SB(b, h) + boff + n * 2048 + k * 1024); } while (0)
#define PG8_MMA(ai, bj, At, Bt) do { __builtin_amdgcn_s_setprio(1); _Pragma("unroll") for (int m = 0; m < 4; ++m) _Pragma("unroll") for (int n = 0; n < 2; ++n) _Pragma("unroll") for (int k = 0; k < 2; ++k) \
        acc[ai][bj][m][n] = __builtin_amdgcn_mfma_f32_16x16x32_bf16(Bt[n][k], At[m][k], acc[ai][bj][m][n], 0, 0, 0); __builtin_amdgcn_s_setprio(0); } while (0)
#define PG8_WAIT_V(n) asm volatile("s_waitcnt vmcnt(" #n ")" ::: "memory")
#define PG8_WAIT_L(n) asm volatile("s_waitcnt lgkmcnt(" #n ")" ::: "memory")
#define PG8_BAR __builtin_amdgcn_s_barrier()
#define PG8_SCHED __builtin_amdgcn_sched_barrier(0)
    Unit cur, nxt; int ui = 0;
    if (!S.next(0, cur)) return;
    f32x4 acc[2][2][4][2];
#pragma unroll
    for (int a = 0; a < 2; ++a)
#pragma unroll
        for (int b = 0; b < 2; ++b)
#pragma unroll
            for (int m = 0; m < 4; ++m)
#pragma unroll
                for (int n = 0; n < 2; ++n) acc[a][b][m][n] = (f32x4){0.f, 0.f, 0.f, 0.f};
    bf16x8 At[4][2], B0[2][2], B1[2][2];
    const char* cA = (const char*)g.A + (size_t)cur.pm * tstep; const char* cB = (const char*)g.Bt + (size_t)cur.pn * tstep;
    S.a_ready(cur);
    PG8_STAGE(PG8_SB(0, 0), cB, voffB); PG8_STAGE(PG8_SA(0, 0), cA, voffA); PG8_STAGE(PG8_SB(0, 1), cB + hstep, voffB); PG8_STAGE(PG8_SA(0, 1), cA + hstep, voffA);
    if (wr == 1) PG8_BAR;
    PG8_WAIT_V(4); PG8_BAR;
    PG8_STAGE(PG8_SB(1, 0), cB + kstep, voffB); PG8_STAGE(PG8_SA(1, 0), cA + kstep, voffA); PG8_STAGE(PG8_SB(1, 1), cB + hstep + kstep, voffB);
    PG8_WAIT_V(6); PG8_BAR;
    PG8_STAMP();
    for (;;) {
        const bool has_next = S.next(ui + 1, nxt);
        const char* nA = has_next ? (const char*)g.A + (size_t)nxt.pm * tstep : cA; const char* nB = has_next ? (const char*)g.Bt + (size_t)nxt.pn * tstep : cB;
        for (int t = 0; t < nt; t += 2) {
            const bool last = (t == nt - 2);
            const char* a1 = cA + (size_t)(t + 1) * kstep;
            const char* a2 = last ? nA : cA + (size_t)(t + 2) * kstep; const char* b2 = last ? nB : cB + (size_t)(t + 2) * kstep;
            const char* a3 = a2 + kstep; const char* b3 = b2 + kstep;
            if (last && has_next) S.a_ready(nxt);
            PG8_LDB(B0, 0, 0); PG8_SCHED; PG8_LDA(At, 0, 0); PG8_STAGE(PG8_SA(1, 1), a1 + hstep, voffA);
            PG8_WAIT_L(8); PG8_BAR; PG8_WAIT_L(0); PG8_MMA(0, 0, At, B0); PG8_BAR; PG8_SCHED;
            PG8_LDB(B1, 0, 1); PG8_STAGE(PG8_SB(0, 0), b2, voffB);
            PG8_BAR; PG8_WAIT_L(0); PG8_MMA(0, 1, At, B1); PG8_BAR;
            PG8_LDA(At, 0, 1); PG8_STAGE(PG8_SA(0, 0), a2, voffA);
            PG8_BAR; PG8_WAIT_L(0); PG8_MMA(1, 0, At, B0); PG8_BAR; PG8_SCHED;
            PG8_STAGE(PG8_SB(0, 1), b2 + hstep, voffB);
            PG8_WAIT_V(6); PG8_BAR; PG8_MMA(1, 1, At, B1); PG8_BAR;
            PG8_LDB(B0, 1, 0); PG8_SCHED; PG8_LDA(At, 1, 0); PG8_STAGE(PG8_SA(0, 1), a2 + hstep, voffA);
            PG8_WAIT_L(8); PG8_BAR; PG8_WAIT_L(0); PG8_MMA(0, 0, At, B0); PG8_BAR; PG8_SCHED;
            PG8_LDB(B1, 1, 1); PG8_STAGE(PG8_SB(1, 0), b3, voffB);
            PG8_BAR; PG8_WAIT_L(0); PG8_MMA(0, 1, At, B1); PG8_BAR;
            PG8_LDA(At, 1, 1); PG8_STAGE(PG8_SA(1, 0), a3, voffA);
            PG8_BAR; PG8_WAIT_L(0); PG8_MMA(1, 0, At, B0); PG8_BAR; PG8_SCHED;
            PG8_STAGE(PG8_SB(1, 1), b3 + hstep, voffB);
            PG8_WAIT_V(6); PG8_BAR; PG8_MMA(1, 1, At, B1); PG8_BAR;
        }
        PG8_STAMP();
        if constexpr (!Epi::AFTER_DRAIN) { E(acc, cur, wr, wc, fr, fq); S.done(cur); }
        PG8_STAMP();
        if (!has_next) break;
#pragma unroll
        for (int a = 0; a < 2; ++a)
#pragma unroll
            for (int b = 0; b < 2; ++b)
#pragma unroll
                for (int m = 0; m < 4; ++m)
#pragma unroll
                    for (int n = 0; n < 2; ++n) acc[a][b][m][n] = (f32x4){0.f, 0.f, 0.f, 0.f};
        cur = nxt; cA = nA; cB = nB; ++ui;
    }
    PG8_WAIT_V(0);
    if (wr == 0) PG8_BAR;
    PG8_BAR;
    if constexpr (Epi::AFTER_DRAIN) { E.fused(acc, cur, wr, wc, fr, fq, lds, wid, lane); S.done(cur); }
    PG8_STAMP();
    if (STAMP && wid == 0) { stamps[lane] = lane < nts ? (((unsigned long long)(unsigned)ts_hi << 32) | (unsigned)ts_lo) : 0ull;
        if (lane == 62) stamps[62] = rt_entry; if (lane == 63) stamps[63] = (unsigned long long)wall_clock64(); }
#undef PG8_STAMP
#undef PG8_SA
#undef PG8_SB
#undef PG8_STAGE
#undef PG8_LDA
#undef PG8_LDB
#undef PG8_MMA
#undef PG8_WAIT_V
#undef PG8_WAIT_L
#undef PG8_BAR
#undef PG8_SCHED
}
}

namespace mk {
constexpr int D = 1024, NB = 8, S = 2048, L = 256, DEPTH = 4;
constexpr int NLAT = NB * S, NCTX = NB * L, NT = NLAT + NCTX;
constexpr int NIN = 2576;
constexpr int NU = 2560;
constexpr int UQ_A = 0, UK_A = 256, UV_A = 384, UZ = 512, UX = 1024, UB = 1536, UC = 1664, UQ_N = 1792, UK_N = 2048, UV_N = 2304;
constexpr int NEXP = 32, DE = 256;
constexpr int MAXSLOT = 45056;
constexpr int MAXTILE = MAXSLOT / 256;
constexpr int NCH = 18;
constexpr int NWAVES = 8, NTHREADS = 512;

typedef unsigned short bf16_t;
typedef short bf16x8 __attribute__((ext_vector_type(8)));
typedef short s16x4 __attribute__((ext_vector_type(4)));
typedef float f32x4 __attribute__((ext_vector_type(4)));
typedef float f32x2 __attribute__((ext_vector_type(2)));
typedef float f32x16 __attribute__((ext_vector_type(16)));
typedef unsigned u32x4 __attribute__((ext_vector_type(4)));
typedef unsigned u32x2 __attribute__((ext_vector_type(2)));

constexpr size_t MiB = 1u << 20;
constexpr size_t WS_CTL = 0, CTL_BYTES = 1 * MiB;
constexpr size_t WS_MODS = 1 * MiB;
constexpr size_t WS_ROPE = 2 * MiB;
constexpr size_t WS_WDT = 2 * MiB + 65536;
constexpr size_t WS_ROUTE = 3 * MiB;
constexpr size_t WS_DT = 5 * MiB;
constexpr size_t WS_BT_IN = 8 * MiB;
constexpr size_t WS_BT_OUT = 28 * MiB;
constexpr size_t WS_BT_GU = 36 * MiB;
constexpr size_t WS_BT_DN = 164 * MiB;
constexpr size_t WS_XW = 228 * MiB;
constexpr size_t WS_H = 300 * MiB;
constexpr size_t WS_U = 336 * MiB;
constexpr size_t WS_O = 426 * MiB;
constexpr size_t WS_HID = 462 * MiB;
constexpr size_t WS_ST = 484 * MiB;
constexpr size_t WS_PREV = 520 * MiB;
constexpr size_t WS_TOT = 538 * MiB;
constexpr size_t WS_END = 539 * MiB;
constexpr size_t RT_SEL = 0;
constexpr size_t RT_POS = 192 * 1024;
constexpr size_t RT_W = 384 * 1024;
constexpr size_t RT_SLOT = 576 * 1024;
constexpr size_t RT_TILE_E = 768 * 1024;
constexpr size_t RT_NTILES = 768 * 1024 + 4096;
constexpr int CW_BAR = 4096, CW_CNT = 16384, CW_POOL = 20480  , CW_TOF = 32768  ;

constexpr int LDS_SCRATCH = 147456;
constexpr int LDS_CTL_OFF = LDS_SCRATCH;
constexpr int LDS_BYTES = LDS_SCRATCH + 1024;

struct Params { const float* in[26]; float* out; unsigned char* ws; };
enum { I_X = 0, I_C, I_CTX, I_CCTX, I_WMOD, I_BMOD, I_GMIX, I_WIN, I_SINK, I_CONVW, I_CONVB, I_DTB, I_ALOG, I_SSDD, I_SSDG, I_RPB, I_WOUT, I_GFFN,
       I_WRG, I_BRG, I_WRE, I_BRE, I_WEG, I_WEU, I_WED, I_GFIN };

__device__ __forceinline__ unsigned f2bf(float f) { unsigned u = __builtin_bit_cast(unsigned, f); return (u + 0x7fffu + ((u >> 16) & 1u)) >> 16; }
__device__ __forceinline__ unsigned pk2(float lo, float hi) { return f2bf(lo) | (f2bf(hi) << 16); }
__device__ __forceinline__ float bf2f(unsigned short b) { return __builtin_bit_cast(float, ((unsigned)b) << 16); }
__device__ __forceinline__ float bflo(unsigned w) { return __builtin_bit_cast(float, w << 16); }
__device__ __forceinline__ float bfhi(unsigned w) { return __builtin_bit_cast(float, w & 0xffff0000u); }
__device__ __forceinline__ float wave_sum(float v) {
#pragma unroll
    for (int o = 1; o < 64; o <<= 1) v += __shfl_xor(v, o);
    return v;
}
__device__ __forceinline__ unsigned cvtpk(float lo, float hi) { typedef __bf16 bf16x2_t __attribute__((ext_vector_type(2))); f32x2 v = {lo, hi}; bf16x2_t b = __builtin_convertvector(v, bf16x2_t); return __builtin_bit_cast(unsigned, b); }
__device__ __forceinline__ float reduce16_transposed(float (&a)[16], int lane) {
    const bool b5 = lane & 32, b4 = lane & 16, b3 = lane & 8, b2 = lane & 4;
    float v8[8];
#pragma unroll
    for (int i = 0; i < 8; ++i) { const float keep = b5 ? a[i + 8] : a[i], send = b5 ? a[i] : a[i + 8]; v8[i] = keep + __shfl_xor(send, 32); }
    float v4[4];
#pragma unroll
    for (int i = 0; i < 4; ++i) { const float keep = b4 ? v8[i + 4] : v8[i], send = b4 ? v8[i] : v8[i + 4]; v4[i] = keep + __shfl_xor(send, 16); }
    float v2[2];
#pragma unroll
    for (int i = 0; i < 2; ++i) { const float keep = b3 ? v4[i + 2] : v4[i], send = b3 ? v4[i] : v4[i + 2]; v2[i] = keep + __shfl_xor(send, 8); }
    float v1; { const float keep = b2 ? v2[1] : v2[0], send = b2 ? v2[0] : v2[1]; v1 = keep + __shfl_xor(send, 4); }
    v1 += __shfl_xor(v1, 2); v1 += __shfl_xor(v1, 1);
    return v1;
}
__device__ __forceinline__ float silu_f(float x) { return x * __builtin_amdgcn_rcpf(1.0f + __expf(-x)); }
__device__ __forceinline__ float softplus_f(float t) { const float x = __expf(t); const float s = x < 0.01f ? x * (1.0f - x * (0.5f - x * (1.0f / 3.0f))) : __logf(1.0f + x); return t > 20.f ? t : s; }
__device__ __forceinline__ int lane_now() { int l; asm volatile("v_mbcnt_lo_u32_b32 %0, -1, 0\n\tv_mbcnt_hi_u32_b32 %0, -1, %0" : "=v"(l)); return l; }
#ifdef MK_SUB
#define MK_TS(c, k, end) do { if ((k) == MK_SUB && (c).bid == 0) { asm volatile("s_waitcnt vmcnt(0) lgkmcnt(0)" ::: "memory"); if ((c).wave == 0 && lane_now() == 0) { volatile LAS unsigned long long* tw = (volatile LAS unsigned long long*)((c).lds + LDS_CTL_OFF + 512); \
    const unsigned long long now_ = __builtin_amdgcn_s_memrealtime(); if (end) tw[1] += now_ - tw[0]; else tw[0] = now_; } } } while (0)
#else
#define MK_TS(c, k, end) do {} while (0)
#endif
#define LDS_WAIT() asm volatile("s_waitcnt lgkmcnt(0)" ::: "memory")
#define VM_WAIT() asm volatile("s_waitcnt vmcnt(0)" ::: "memory")
}
namespace mk {
struct Ctx {
    LAS unsigned char* lds; int wave, G, bid;
    const Params* P; unsigned char* ws;
};

__device__ __forceinline__ Ctx fresh(const Ctx& c) {
    Ctx n = c; asm volatile("" : "+s"(n.wave), "+s"(n.G), "+s"(n.bid));
    { __attribute__((address_space(1))) unsigned char* g = (__attribute__((address_space(1))) unsigned char*)n.ws; asm volatile("" : "+s"(g)); n.ws = (unsigned char*)g; }
    return n; }
__device__ __forceinline__ void tr_item(const float* W, size_t ldw, bf16_t* dst, size_t ldd, int k0, LAS float* scr, int lane) {
#pragma unroll 8
    for (int i = 0; i < 32; ++i) { const int kk = 2 * i + (lane >> 5); scr[kk * 33 + (lane & 31)] = __builtin_nontemporal_load(W + (size_t)(k0 + kk) * ldw + (lane & 31)); }
    LDS_WAIT(); asm volatile("" ::: "memory");
    const int c = lane & 7;
#pragma unroll
    for (int j = 0; j < 4; ++j) { const int n = (lane >> 3) + 8 * j; const LAS float* s = scr + (8 * c) * 33 + n;
        u32x4 o; o.x = cvtpk(s[0 * 33], s[1 * 33]); o.y = cvtpk(s[2 * 33], s[3 * 33]); o.z = cvtpk(s[4 * 33], s[5 * 33]); o.w = cvtpk(s[6 * 33], s[7 * 33]);
        __builtin_nontemporal_store(o, (u32x4*)(dst + (size_t)n * ldd + k0 + 8 * c)); }
    LDS_WAIT(); asm volatile("" ::: "memory");
}

__device__ __forceinline__ void convert_layer(const Ctx& c, int l, int scr_off) {
    const Params& P = *c.P; const int lane = lane_now();
    LAS float* scr = (LAS float*)(c.lds + scr_off + c.wave * 8448);
    const int gw = c.bid * NWAVES + c.wave, NGW = c.G * NWAVES;
    constexpr int IT_IN = 16 * 80, IT_OUT = 16 * 32, IT_G = 32 * 16 * 8, IT_D = 32 * 4 * 32, IT_L = IT_IN + IT_OUT + 2 * IT_G + IT_D;
    bf16_t* bt_in = (bf16_t*)(c.ws + WS_BT_IN); bf16_t* bt_out = (bf16_t*)(c.ws + WS_BT_OUT); bf16_t* bt_gu = (bf16_t*)(c.ws + WS_BT_GU); bf16_t* bt_dn = (bf16_t*)(c.ws + WS_BT_DN);
    for (int it = gw; it < IT_L; it += NGW) {
        int r = it;
        if (r < IT_IN) { const int kb = r / 80, nb = r % 80; const int n0 = nb * 32, ns = n0 < 1792 ? n0 : n0 + 16;
            tr_item(P.in[I_WIN] + (size_t)l * 1024 * NIN + ns, NIN, bt_in + ((size_t)l * NU + n0) * 1024, 1024, kb * 64, scr, lane); continue; }
        r -= IT_IN;
        if (r < IT_OUT) { const int kb = r / 32, nb = r % 32;
            tr_item(P.in[I_WOUT] + (size_t)l * 1024 * 1024 + nb * 32, 1024, bt_out + ((size_t)l * 1024 + nb * 32) * 1024, 1024, kb * 64, scr, lane); continue; }
        r -= IT_OUT;
        if (r < 2 * IT_G) { const int up = r >= IT_G; if (up) r -= IT_G; const int e = r / 128, q = r % 128, kb = q / 8, nb = q % 8; const int f0 = nb * 32;
            const float* src = P.in[up ? I_WEU : I_WEG] + ((size_t)(l * 32 + e) * 1024) * 256 + f0;
            bf16_t* dst = bt_gu + (((size_t)(l * 32 + e) * 2 + (f0 >> 7)) * 256 + (up ? 128 : 0) + (f0 & 127)) * 1024;
            tr_item(src, 256, dst, 1024, kb * 64, scr, lane); continue; }
        r -= 2 * IT_G;
        { const int e = r / 128, q = r % 128, kb = q / 32, nb = q % 32;
            tr_item(P.in[I_WED] + ((size_t)(l * 32 + e) * 256) * 1024 + nb * 32, 1024, bt_dn + ((size_t)(l * 32 + e) * 1024 + nb * 32) * 256, 256, kb * 64, scr, lane); }
    }
}

__device__ __forceinline__ void phase_p0a(const Ctx& c) {
    const Params& P = *c.P; const int c_lane = lane_now(), c_tid = c.wave * 64 + c_lane;
    LAS float* sc = (LAS float*)c.lds;
    LAS float* red = (LAS float*)(c.lds + 36864);
    for (int i = c_tid; i < 9 * 1024; i += NTHREADS) { const int bb = i >> 10, k = i & 1023; const float v = bb < 8 ? P.in[I_C][bb * 1024 + k] : P.in[I_CCTX][k]; sc[i] = silu_f(v); }
    __syncthreads();
    float* mods = (float*)(c.ws + WS_MODS);
    for (int bi = c.bid; bi < DEPTH * 96; bi += c.G) {
        const int l = bi / 96, n = (bi % 96) * 64 + c_lane;
        const float* w = P.in[I_WMOD] + (size_t)l * 1024 * 6144 + n;
        float acc[9];
#pragma unroll
        for (int bb = 0; bb < 9; ++bb) acc[bb] = 0.f;
        const int kb = c.wave * 128;
#pragma unroll 8
        for (int k = 0; k < 128; ++k) { const float wv = __builtin_nontemporal_load(w + (size_t)(kb + k) * 6144);
#pragma unroll
            for (int bb = 0; bb < 9; ++bb) acc[bb] += sc[bb * 1024 + kb + k] * wv; }
#pragma unroll
        for (int bb = 0; bb < 9; ++bb) red[(c.wave * 9 + bb) * 64 + c_lane] = acc[bb];
        __syncthreads();
        for (int i = c_tid; i < 9 * 64; i += NTHREADS) { const int bb = i >> 6, ln = i & 63; float s = 0.f;
#pragma unroll
            for (int w8 = 0; w8 < 8; ++w8) s += red[(w8 * 9 + bb) * 64 + ln];
            const int nn = (bi % 96) * 64 + ln;
            mods[((size_t)l * 9 + bb) * 6144 + nn] = s + P.in[I_BMOD][l * 6144 + nn]; }
        __syncthreads();
    }
    const int gt = c.bid * NTHREADS + c_tid, NGT = c.G * NTHREADS;
    { f32x2* rope = (f32x2*)(c.ws + WS_ROPE);
      for (int i = gt; i < 64 * 16; i += NGT) { const int pos = i >> 4, fi = i & 15; const float inv = 1.0f / powf(10000.0f, (float)(2 * fi) / 32.0f); const float ang = (float)pos * inv;
          rope[i] = (f32x2){cosf(ang), sinf(ang)}; }
      float* wdt = (float*)(c.ws + WS_WDT);
      for (int i = gt; i < DEPTH * 16 * 1024; i += NGT) { const int k = i & 1023, jd = (i >> 10) & 15, l = i >> 14; wdt[i] = P.in[I_WIN][((size_t)l * 1024 + k) * NIN + 1792 + jd]; } }
    for (int l = 0; l < DEPTH; ++l) convert_layer(c, l, 36864 + 18432);
}

__device__ __forceinline__ void norm_row(const float* xrow, const float* g, const float* shift, const float* scale, bf16_t* hrow, const LAS float* wdt, const float* dtb, float* dtrow, int lane) {
    const f32x4* xr = (const f32x4*)xrow + lane; f32x4 v[4]; float ss = 0.f;
#pragma unroll
    for (int j = 0; j < 4; ++j) { v[j] = xr[64 * j]; ss += (v[j].x * v[j].x + v[j].y * v[j].y) + (v[j].z * v[j].z + v[j].w * v[j].w); }
    const float rstd = __builtin_amdgcn_rsqf(wave_sum(ss) * (1.0f / 1024.0f) + 1e-6f);
#pragma unroll
    for (int j = 0; j < 4; ++j) { const f32x4 gg = ((const f32x4*)g)[lane + 64 * j], sh = ((const f32x4*)shift)[lane + 64 * j], sl = ((const f32x4*)scale)[lane + 64 * j];
        v[j] = (v[j] * rstd) * gg * (sl + 1.0f) + sh;
        u32x2 o; o.x = cvtpk(v[j].x, v[j].y); o.y = cvtpk(v[j].z, v[j].w); ((u32x2*)hrow)[lane + 64 * j] = o; }
    {
        float pa[16];
#pragma unroll
        for (int jd = 0; jd < 16; ++jd) { float a = 0.f;
#pragma unroll
            for (int j = 0; j < 4; ++j) { const f32x4 w = ((const LAS f32x4*)(wdt + jd * 1024))[lane + 64 * j]; a += (v[j].x * w.x + v[j].y * w.y) + (v[j].z * w.z + v[j].w * w.w); }
            pa[jd] = a; if ((jd & 3) == 3) __builtin_amdgcn_sched_barrier(0); }
        const float tot = reduce16_transposed(pa, lane); const int jd_l = ((lane >> 5) & 1) * 8 + ((lane >> 4) & 1) * 4 + ((lane >> 3) & 1) * 2 + ((lane >> 2) & 1);
        if ((lane & 3) == 0) dtrow[jd_l] = softplus_f(tot + dtb[jd_l]);
    }
}
__device__ __forceinline__ void phase_norm1(const Ctx& c, int l, const float* xlat, const float* xctx) {
    const Params& P = *c.P; const float* mods = (const float*)(c.ws + WS_MODS) + (size_t)l * 9 * 6144;
    bf16_t* H = (bf16_t*)(c.ws + WS_H); float* dtv = (float*)(c.ws + WS_DT); const float* wdt_g = (const float*)(c.ws + WS_WDT) + (size_t)l * 16 * 1024;
    const int gw = c.bid * NWAVES + c.wave, NGW = c.G * NWAVES; const int c_lane = lane_now();
    LAS float* wdt = (LAS float*)c.lds;
    for (int i = c.wave * 64 + c_lane; i < 16 * 256; i += NTHREADS) ((LAS f32x4*)wdt)[i] = ((const f32x4*)wdt_g)[i];
    __syncthreads();
    for (int row = gw; row < NT; row += NGW) {
        const int bb = row < NLAT ? row >> 11 : 8; const float* xr = row < NLAT ? xlat + (size_t)row * 1024 : xctx + (size_t)(row - NLAT) * 1024;
        norm_row(xr, P.in[I_GMIX] + l * 1024, mods + bb * 6144, mods + bb * 6144 + 1024, H + (size_t)row * 1024, wdt, P.in[I_DTB] + l * 16, dtv + (size_t)row * 16, c_lane);
    }
}

constexpr float QSCALE_Q = 0.125f * 1.4426950408889634f;
struct EpiInProj {
    static constexpr bool PERM = false, AFTER_DRAIN = false;
    bf16_t* U; const f32x2* rope;
    __device__ __forceinline__ void operator()(const pg8::f32x4 (&acc)[2][2][4][2], const pg8::Unit& u, int wr, int wc, int fr, int fq) const {
        const int row0 = u.pm * 256 + wr * 64 + fr, col0 = u.pn * 256 + wc * 32 + 4 * fq;
#pragma unroll
        for (int bj = 0; bj < 2; ++bj) {
            const int cb = u.pn * 256 + bj * 128 + wc * 32;
            const bool do_rope = (u.pm < 64) && (cb < 384); const bool is_q = (cb < 256) || (cb >= 1792 && cb < 2048);
#pragma unroll
            for (int ai = 0; ai < 2; ++ai)
#pragma unroll
                for (int m = 0; m < 4; ++m) {
                    const int row = row0 + ai * 128 + m * 16;
                    pg8::f32x4 x1 = acc[ai][bj][m][0], x2 = acc[ai][bj][m][1];
                    if (do_rope) { const int t = row & 2047; const int pos = ((cb >> 5) & 1) ? (t & 63) : (t >> 6);
                        const f32x4* rp = (const f32x4*)(rope + pos * 16 + 4 * fq); const f32x4 r0 = rp[0], r1 = rp[1];
                        const pg8::f32x4 cs = {r0.x, r0.z, r1.x, r1.z}, sn = {r0.y, r0.w, r1.y, r1.w};
                        const pg8::f32x4 y1 = x1 * cs - x2 * sn, y2 = x2 * cs + x1 * sn; x1 = y1; x2 = y2; }
                    if (is_q) { x1 = x1 * QSCALE_Q; x2 = x2 * QSCALE_Q; }
                    bf16_t* rowp = U + (size_t)row * NU + col0 + bj * 128;
                    u32x2 o1, o2; o1.x = cvtpk(x1[0], x1[1]); o1.y = cvtpk(x1[2], x1[3]); o2.x = cvtpk(x2[0], x2[1]); o2.y = cvtpk(x2[2], x2[3]);
                    *(u32x2*)rowp = o1; *(u32x2*)(rowp + 16) = o2;
                }
        }
    }
};
struct EpiOutProj {
    static constexpr bool PERM = false, AFTER_DRAIN = false;
    const float* xlat; const float* xctx; float* xw; const float* mods_l;
    __device__ __forceinline__ void operator()(const pg8::f32x4 (&acc)[2][2][4][2], const pg8::Unit& u, int wr, int wc, int fr, int fq) const {
        const int row0 = u.pm * 256 + wr * 64 + fr, col0 = u.pn * 256 + wc * 32 + 4 * fq;
        const int bb = u.pm < 64 ? (u.pm >> 3) : 8; const float* gate = mods_l + bb * 6144 + 2 * 1024;
        const float* src = u.pm < 64 ? xlat : xctx - (size_t)NLAT * 1024;
        f32x4 gv[2][2];
#pragma unroll
        for (int bj = 0; bj < 2; ++bj)
#pragma unroll
            for (int n = 0; n < 2; ++n) gv[bj][n] = *(const f32x4*)(gate + col0 + bj * 128 + n * 16);
#pragma unroll
        for (int ai = 0; ai < 2; ++ai)
#pragma unroll
            for (int m = 0; m < 4; ++m) { const size_t off = (size_t)(row0 + ai * 128 + m * 16) * 1024 + col0;
#pragma unroll
                for (int bj = 0; bj < 2; ++bj)
#pragma unroll
                    for (int n = 0; n < 2; ++n) { const f32x4 xo = *(const f32x4*)(src + off + bj * 128 + n * 16); const pg8::f32x4 a = acc[ai][bj][m][n];
                        f32x4 r; r.x = xo.x + gv[bj][n].x * a[0]; r.y = xo.y + gv[bj][n].y * a[1]; r.z = xo.z + gv[bj][n].z * a[2]; r.w = xo.w + gv[bj][n].w * a[3];
                        *(f32x4*)(xw + off + bj * 128 + n * 16) = r; } }
    }
};
struct EpiGateUp {
    static constexpr bool PERM = false, AFTER_DRAIN = false;
    bf16_t* HID;
    __device__ __forceinline__ void operator()(const pg8::f32x4 (&acc)[2][2][4][2], const pg8::Unit& u, int wr, int wc, int fr, int fq) const {
        const int row0 = u.pm * 256 + wr * 64 + fr, col0 = (u.pn & 1) * 128 + wc * 32 + 4 * fq;
#pragma unroll
        for (int ai = 0; ai < 2; ++ai)
#pragma unroll
            for (int m = 0; m < 4; ++m) { bf16_t* rowp = HID + (size_t)(row0 + ai * 128 + m * 16) * 256 + col0;
#pragma unroll
                for (int n = 0; n < 2; ++n) { const pg8::f32x4 g = acc[ai][0][m][n], up = acc[ai][1][m][n]; float h[4];
#pragma unroll
                    for (int i = 0; i < 4; ++i) h[i] = g[i] * __builtin_amdgcn_rcpf(1.0f + __expf(-g[i])) * up[i];
                    u32x2 o; o.x = cvtpk(h[0], h[1]); o.y = cvtpk(h[2], h[3]); *(u32x2*)(rowp + n * 16) = o; } }
    }
};
struct EpiDown {
    static constexpr bool PERM = false, AFTER_DRAIN = false;
    bf16_t* OUT;
    __device__ __forceinline__ void operator()(const pg8::f32x4 (&acc)[2][2][4][2], const pg8::Unit& u, int wr, int wc, int fr, int fq) const {
        const int row0 = u.pm * 256 + wr * 64 + fr, col0 = (u.pn & 3) * 256 + wc * 32 + 4 * fq;
#pragma unroll
        for (int ai = 0; ai < 2; ++ai)
#pragma unroll
            for (int m = 0; m < 4; ++m) { bf16_t* rowp = OUT + (size_t)(row0 + ai * 128 + m * 16) * 1024 + col0;
#pragma unroll
                for (int bj = 0; bj < 2; ++bj)
#pragma unroll
                    for (int n = 0; n < 2; ++n) { const pg8::f32x4 a = acc[ai][bj][m][n]; u32x2 o; o.x = cvtpk(a[0], a[1]); o.y = cvtpk(a[2], a[3]); *(u32x2*)(rowp + bj * 128 + n * 16) = o; } }
    }
};
template <int NSUB> struct ExpertOrder {
    const int* tile_e; int ntiles, G, c;
    __device__ __forceinline__ bool next(int i, pg8::Unit& u) const {
        const long Lx = (long)i * G + c; if (Lx >= (long)ntiles * NSUB) return false;
        const int tile = (int)(Lx / NSUB), sub = (int)(Lx % NSUB); u.pm = tile; u.pn = __builtin_amdgcn_readfirstlane(tile_e[tile]) * NSUB + sub; return true; }
    __device__ __forceinline__ void a_ready(const pg8::Unit&) const {}
    __device__ __forceinline__ void done(const pg8::Unit&) const {}
};
}
namespace mk {
__device__ __forceinline__ int crow(int r, int hi) { return (r & 3) + 8 * (r >> 2) + 4 * hi; }
typedef short v4i16_t __attribute__((ext_vector_type(4)));
__device__ __forceinline__ s16x4 lds_tr(const LAS unsigned char* p) { return __builtin_bit_cast(s16x4, __builtin_amdgcn_ds_read_tr16_b64_v4i16((LAS v4i16_t*)p)); }

__device__ __forceinline__ f32x16 zero16() { f32x16 z;
#pragma unroll
    for (int r = 0; r < 16; ++r) z[r] = 0.f;
    asm volatile("" : "+v"(z)); return z; }
constexpr int AT_K = 0, AT_V = 16384, AT_BIAS = 32768, AT_BYTES = 32768 + 2048;
constexpr float LOG2E = 1.4426950408889634f, QSCALE = 0.125f * 1.4426950408889634f;

template <int TYPE> __device__ __forceinline__ void attn_unit(const Ctx& c, int l, int ua, int ub, int uc) {
    const Params& P = *c.P; const bf16_t* U = (const bf16_t*)(c.ws + WS_U); bf16_t* O = (bf16_t*)(c.ws + WS_O);
    const int tid_l = c.wave * 64 + lane_now();
    const int lane = tid_l & 63, w = c.wave, r32 = lane & 31, hi = lane >> 5;
    LAS unsigned char* lds = c.lds;
    int b = ua, qrow, qcol, ocol, kcol, vcol, ntl, ntiles; float sinkv = 0.f; bool has_sink = false;
    int qpos = 0, kpos_base = 0;
    int qr = 0, qc = 0, rmin = 0, rs_w = 0, cs_q = 0, rs_q = 0, ks = 0;
    if (TYPE == 0) { const int n = ub, g = uc; const int qh = 2 * g + (w >> 2); qpos = n * 128 + (w & 3) * 32 + r32; qrow = b * S + qpos; qcol = UQ_A + qh * 64; ocol = qh * 64; kcol = UK_A + g * 64; vcol = UV_A + g * 64;
        kpos_base = n * 128 - 128; ntl = 6; has_sink = true; sinkv = P.in[I_SINK][l * 4 + qh]; }
    else if (TYPE == 1) { const int rg = ub, h = uc; qr = 4 * rg + 2 * (w >> 2) + (r32 >> 4); qc = 16 * (w & 3) + (r32 & 15); qrow = b * S + qr * 64 + qc; qcol = UQ_N + h * 64; ocol = 768 + h * 64; kcol = UK_N + h * 64; vcol = UV_N + h * 64;
        int r0 = 4 * rg - 4; if (r0 < 0) r0 = 0; if (r0 > 24) r0 = 24; rmin = r0; int r1 = 4 * rg + 3 - 4; if (r1 < 0) r1 = 0; if (r1 > 24) r1 = 24; ntl = r1 + 8 - rmin;
        rs_q = qr - 4; if (rs_q < 0) rs_q = 0; if (rs_q > 24) rs_q = 24; cs_q = qc - 8; if (cs_q < 0) cs_q = 0; if (cs_q > 48) cs_q = 48;
        { const int r0w = 4 * rg + 2 * (w >> 2); rs_w = r0w - 4; if (rs_w < 0) rs_w = 0; if (rs_w > 24) rs_w = 24; const int cb = w & 3; ks = cb == 0 ? 0 : (cb == 1 ? 8 : (cb == 2 ? 24 : 32)); } }
    else { const int hh = ub; qrow = NLAT + b * L + w * 32 + r32; ntl = 0;
        if (hh < 4) { qcol = UQ_A + hh * 64; ocol = hh * 64; kcol = UK_A + (hh >> 1) * 64; vcol = UV_A + (hh >> 1) * 64; has_sink = true; sinkv = P.in[I_SINK][l * 4 + hh]; }
        else { const int h = hh - 4; qcol = UQ_N + h * 64; ocol = 768 + h * 64; kcol = UK_N + h * 64; vcol = UV_N + h * 64; } }
    ntiles = ntl + 4;
    if (TYPE == 1) { LAS float* bt = (LAS float*)(lds + AT_BIAS); const float* src = P.in[I_RPB] + (size_t)(l * 4 + uc) * 465; for (int i = tid_l; i < 465; i += NTHREADS) bt[i] = src[i] * LOG2E; }
    bf16x8 qf[4];
#pragma unroll
    for (int d0 = 0; d0 < 4; ++d0) qf[d0] = *(const bf16x8*)(U + (size_t)qrow * NU + qcol + d0 * 16 + hi * 8);
    f32x16 o0 = zero16(), o1 = zero16(); float m = -1e30f, lsum = 0.f;
    auto tile_row = [&](int t) -> int {
        if (t >= ntl) return NLAT + b * L + (t - ntl) * 64;
        if (TYPE == 0) { const int kp = kpos_base + 64 * t; return (kp < 0 || kp >= S) ? -1 : b * S + kp; }
        if (TYPE == 1) return b * S + (rmin + t) * 64;
        return -1; };
    auto stage = [&](int t, int slot) {
        const int kr0 = tile_row(t); if (kr0 < 0) return;
        const bf16_t* ks = U + (size_t)(kr0 + lane) * NU + kcol + 8 * w;
        const bf16_t* vs = U + (size_t)(kr0 + 16 * (w & 3) + (lane >> 2)) * NU + vcol + (w >> 2) * 32 + (lane & 3) * 8;
        __builtin_amdgcn_global_load_lds((const unsigned*)ks, (LAS unsigned*)(lds + AT_K + slot * 8192 + w * 1024), 16, 0, 0);
        __builtin_amdgcn_global_load_lds((const unsigned*)vs, (LAS unsigned*)(lds + AT_V + slot * 8192 + w * 1024), 16, 0, 0); };
    stage(0, 0);
    for (int t = 0; t < ntiles; ++t) {
        VM_WAIT(); __syncthreads();
        if (t + 1 < ntiles) stage(t + 1, (t + 1) & 1);
        const int kr0 = tile_row(t);
        bool active = kr0 >= 0; int maskmode = 0;
        if (t < ntl) {
            if (TYPE == 0) { const int q0 = qpos - r32, k0 = kpos_base + 64 * t;
                const int dmin = (k0 > q0 + 31) ? k0 - (q0 + 31) : ((q0 > k0 + 63) ? q0 - (k0 + 63) : 0);
                const int dmax = (q0 + 31 - k0) > (k0 + 63 - q0) ? (q0 + 31 - k0) : (k0 + 63 - q0);
                if (dmin > 128) active = false; maskmode = dmax > 128 ? 1 : 0; }
            if (TYPE == 1) { const int kr = rmin + t; if (kr < rs_w || kr > rs_w + 8) active = false; maskmode = 1; }
        }
        if (TYPE == 1 && active && t < ntl) {
            const int kr = rmin + t;
            const LAS unsigned char* Ks = lds + AT_K + (t & 1) * 8192 + hi * 1024 + (ks + r32) * 16;
            f32x16 p0 = zero16();
#pragma unroll
            for (int d0 = 0; d0 < 4; ++d0) p0 = __builtin_amdgcn_mfma_f32_32x32x16_bf16(*(const LAS bf16x8*)(Ks + d0 * 2048), qf[d0], p0, 0, 0, 0);
            const bool rowok = (unsigned)(kr - rs_q) < 8u;
            const LAS float* bt = (const LAS float*)(lds + AT_BIAS) + (kr - qr + 7) * 31 - qc + 15 + ks;
            float rm = -1e30f;
#pragma unroll
            for (int r = 0; r < 16; ++r) { const int kc = ks + crow(r, hi); const bool v0 = rowok && (unsigned)(kc - cs_q) < 16u; const float b0 = v0 ? bt[crow(r, hi)] : 0.f;
                p0[r] = v0 ? p0[r] + b0 : -1e30f; rm = fmaxf(rm, p0[r]); }
            rm = fmaxf(rm, __shfl_xor(rm, 32));
            const float mn = fmaxf(m, rm); const float alpha = __builtin_amdgcn_exp2f(m - mn); m = mn;
            float ps = 0.f;
#pragma unroll
            for (int r = 0; r < 16; ++r) { p0[r] = p0[r] > -1e29f ? __builtin_amdgcn_exp2f(p0[r] - mn) : 0.f; ps += p0[r]; }
            lsum = lsum * alpha + ps;
#pragma unroll
            for (int r = 0; r < 16; ++r) { o0[r] *= alpha; o1[r] *= alpha; }
            u32x4 t0 = {cvtpk(p0[0], p0[1]), cvtpk(p0[2], p0[3]), cvtpk(p0[4], p0[5]), cvtpk(p0[6], p0[7])}, t1 = {cvtpk(p0[8], p0[9]), cvtpk(p0[10], p0[11]), cvtpk(p0[12], p0[13]), cvtpk(p0[14], p0[15])};
            const bf16x8 pa0 = __builtin_bit_cast(bf16x8, t0), pa1 = __builtin_bit_cast(bf16x8, t1);
            const LAS unsigned char* Vs = lds + AT_V + (t & 1) * 8192 + (ks + 4 * hi + ((lane & 15) >> 2)) * 64 + ((lane >> 4) & 1) * 32 + (lane & 3) * 8;
#pragma unroll
            for (int s2 = 0; s2 < 2; ++s2) {
                const s16x4 a0 = lds_tr(Vs + s2 * 1024), a1 = lds_tr(Vs + s2 * 1024 + 512), b0 = lds_tr(Vs + 4096 + s2 * 1024), b1 = lds_tr(Vs + 4096 + s2 * 1024 + 512);
                const bf16x8 v0 = {a0[0], a0[1], a0[2], a0[3], a1[0], a1[1], a1[2], a1[3]}, v1 = {b0[0], b0[1], b0[2], b0[3], b1[0], b1[1], b1[2], b1[3]};
                o0 = __builtin_amdgcn_mfma_f32_32x32x16_bf16(v0, s2 == 0 ? pa0 : pa1, o0, 0, 0, 0); o1 = __builtin_amdgcn_mfma_f32_32x32x16_bf16(v1, s2 == 0 ? pa0 : pa1, o1, 0, 0, 0); }
        } else
        if (active) {
            const LAS unsigned char* Ks = lds + AT_K + (t & 1) * 8192 + hi * 1024 + r32 * 16;
            f32x16 p0 = zero16(), p1 = zero16();
#pragma unroll
            for (int d0 = 0; d0 < 4; ++d0) { const bf16x8 k0f = *(const LAS bf16x8*)(Ks + d0 * 2048), k1f = *(const LAS bf16x8*)(Ks + d0 * 2048 + 512);
                p0 = __builtin_amdgcn_mfma_f32_32x32x16_bf16(k0f, qf[d0], p0, 0, 0, 0); p1 = __builtin_amdgcn_mfma_f32_32x32x16_bf16(k1f, qf[d0], p1, 0, 0, 0); }
            if (maskmode == 0) {
#pragma unroll
                for (int r = 0; r < 16; ++r) { }
            } else if (TYPE == 0) { const int kb = kpos_base + 64 * t;
#pragma unroll
                for (int r = 0; r < 16; ++r) { const int k0 = kb + crow(r, hi), k1 = k0 + 32; int d0 = qpos - k0; d0 = d0 < 0 ? -d0 : d0; int d1 = qpos - k1; d1 = d1 < 0 ? -d1 : d1;
                    p0[r] = d0 <= 128 ? p0[r] : -1e30f; p1[r] = d1 <= 128 ? p1[r] : -1e30f; }
            } else if (TYPE == 1) { const LAS float* bt = (const LAS float*)(lds + AT_BIAS) + (rmin + t - qr + 7) * 31 - qc + 15;
#pragma unroll
                for (int r = 0; r < 16; ++r) { const int k0 = crow(r, hi), k1 = k0 + 32; const bool v0 = (unsigned)(k0 - cs_q) < 16u, v1 = (unsigned)(k1 - cs_q) < 16u;
                    const float b0 = v0 ? bt[k0] : 0.f, b1 = v1 ? bt[k1] : 0.f;
                    p0[r] = v0 ? p0[r] + b0 : -1e30f; p1[r] = v1 ? p1[r] + b1 : -1e30f; }
            }
            float rm = fmaxf(p0[0], p1[0]);
#pragma unroll
            for (int r = 1; r < 16; ++r) rm = fmaxf(rm, fmaxf(p0[r], p1[r]));
            rm = fmaxf(rm, __shfl_xor(rm, 32));
            const float mn = fmaxf(m, rm); const float alpha = __builtin_amdgcn_exp2f(m - mn); m = mn;
            float ps = 0.f;
            if (maskmode == 0) {
#pragma unroll
                for (int r = 0; r < 16; ++r) { p0[r] = __builtin_amdgcn_exp2f(p0[r] - mn); p1[r] = __builtin_amdgcn_exp2f(p1[r] - mn); ps += p0[r] + p1[r]; }
            } else {
#pragma unroll
                for (int r = 0; r < 16; ++r) { p0[r] = p0[r] > -1e29f ? __builtin_amdgcn_exp2f(p0[r] - mn) : 0.f; p1[r] = p1[r] > -1e29f ? __builtin_amdgcn_exp2f(p1[r] - mn) : 0.f; ps += p0[r] + p1[r]; }
            }
            lsum = lsum * alpha + ps;
#pragma unroll
            for (int r = 0; r < 16; ++r) { o0[r] *= alpha; o1[r] *= alpha; }
            bf16x8 pa[4];
            { u32x4 t0 = {cvtpk(p0[0], p0[1]), cvtpk(p0[2], p0[3]), cvtpk(p0[4], p0[5]), cvtpk(p0[6], p0[7])}; pa[0] = __builtin_bit_cast(bf16x8, t0);
              u32x4 t1 = {cvtpk(p0[8], p0[9]), cvtpk(p0[10], p0[11]), cvtpk(p0[12], p0[13]), cvtpk(p0[14], p0[15])}; pa[1] = __builtin_bit_cast(bf16x8, t1);
              u32x4 t2 = {cvtpk(p1[0], p1[1]), cvtpk(p1[2], p1[3]), cvtpk(p1[4], p1[5]), cvtpk(p1[6], p1[7])}; pa[2] = __builtin_bit_cast(bf16x8, t2);
              u32x4 t3 = {cvtpk(p1[8], p1[9]), cvtpk(p1[10], p1[11]), cvtpk(p1[12], p1[13]), cvtpk(p1[14], p1[15])}; pa[3] = __builtin_bit_cast(bf16x8, t3); }
            const LAS unsigned char* Vs = lds + AT_V + (t & 1) * 8192 + (4 * hi + ((lane & 15) >> 2)) * 64 + ((lane >> 4) & 1) * 32 + (lane & 3) * 8;
#pragma unroll
            for (int ks = 0; ks < 4; ++ks) {
                const s16x4 a0 = lds_tr(Vs + ks * 1024), a1 = lds_tr(Vs + ks * 1024 + 512), b0 = lds_tr(Vs + 4096 + ks * 1024), b1 = lds_tr(Vs + 4096 + ks * 1024 + 512);
                const bf16x8 v0 = {a0[0], a0[1], a0[2], a0[3], a1[0], a1[1], a1[2], a1[3]}, v1 = {b0[0], b0[1], b0[2], b0[3], b1[0], b1[1], b1[2], b1[3]};
                o0 = __builtin_amdgcn_mfma_f32_32x32x16_bf16(v0, pa[ks], o0, 0, 0, 0); o1 = __builtin_amdgcn_mfma_f32_32x32x16_bf16(v1, pa[ks], o1, 0, 0, 0); }
        }
    }
    lsum += __shfl_xor(lsum, 32);
    if (has_sink) { const float s2 = sinkv * LOG2E; const float mn = fmaxf(m, s2); const float alpha = __builtin_amdgcn_exp2f(m - mn); lsum = lsum * alpha + __builtin_amdgcn_exp2f(s2 - mn);
#pragma unroll
        for (int r = 0; r < 16; ++r) { o0[r] *= alpha; o1[r] *= alpha; } }
    const float il = 1.0f / lsum;
    bf16_t* orow = O + (size_t)qrow * 1024 + ocol + 4 * hi;
#pragma unroll
    for (int g4 = 0; g4 < 4; ++g4) { u32x2 a, bq; a.x = cvtpk(o0[4 * g4] * il, o0[4 * g4 + 1] * il); a.y = cvtpk(o0[4 * g4 + 2] * il, o0[4 * g4 + 3] * il);
        bq.x = cvtpk(o1[4 * g4] * il, o1[4 * g4 + 1] * il); bq.y = cvtpk(o1[4 * g4 + 2] * il, o1[4 * g4 + 3] * il);
        *(u32x2*)(orow + 8 * g4) = a; *(u32x2*)(orow + 32 + 8 * g4) = bq; }
    VM_WAIT(); __syncthreads();
}

__device__ __forceinline__ void ctx_outproj_tile(const Ctx& c, int l, int tile) {
    const int lane = lane_now(), r32 = lane & 31, hi = lane >> 5, w = c.wave;
    const int r0 = 64 * (tile >> 3) + 32 * (w >> 2), c0 = 128 * (tile & 7) + 32 * (w & 3);
    const bf16_t* A = (const bf16_t*)(c.ws + WS_O) + (size_t)(NLAT + r0 + r32) * 1024 + 8 * hi;
    const bf16_t* B = (const bf16_t*)(c.ws + WS_BT_OUT) + ((size_t)l * 1024 + c0 + r32) * 1024 + 8 * hi;
    f32x16 acc = zero16();
#pragma unroll 8
    for (int s = 0; s < 64; ++s) { const bf16x8 af = *(const bf16x8*)(A + 16 * s), bf = *(const bf16x8*)(B + 16 * s); acc = __builtin_amdgcn_mfma_f32_32x32x16_bf16(af, bf, acc, 0, 0, 0); }
    float* xw = (float*)(c.ws + WS_XW) + (size_t)NLAT * 1024; const float* xs = l == 0 ? c.P->in[I_CTX] : xw;
    const float gate = ((const float*)(c.ws + WS_MODS))[((size_t)l * 9 + 8) * 6144 + 2 * 1024 + c0 + r32];
#pragma unroll
    for (int r = 0; r < 16; ++r) { const size_t off = (size_t)(r0 + crow(r, hi)) * 1024 + c0 + r32; xw[off] = xs[off] + gate * acc[r]; }
}
}
namespace mk {
__device__ __forceinline__ int chunk_row(int b, int cidx, int& t0, int& len) { if (cidx < 2) { t0 = 128 * cidx; len = L; return NLAT + b * L + t0; } t0 = 128 * (cidx - 2); len = S; return b * S + t0; }

constexpr int SD_X = 0;
constexpr int SD_B = 65536;
constexpr int SD_C = 81920;
constexpr int SD_WT = 98304;
constexpr int SD_WV = 106496;
constexpr int SD_MISC = 110592;
constexpr int SD_SSQ = 110720;
constexpr int SD_BYTES = 114816;

template <bool WITH_C, bool B_TR> __device__ __forceinline__ void ssd_conv_stage(const Ctx& c, int l, int g, int rowbase, int t0, int len) {
    const Params& P = *c.P; const bf16_t* U = (const bf16_t*)(c.ws + WS_U);
    const float* cw = P.in[I_CONVW] + (size_t)l * 5 * 768; const float* cb = P.in[I_CONVB] + (size_t)l * 768;
    constexpr int NCG = WITH_C ? 48 : 40;
    const int tid_l = c.wave * 64 + lane_now();
    for (int it = tid_l; it < NCG * 16; it += NTHREADS) {
        const int cg = it % NCG, seg = it / NCG; const int tb = seg * 8;
        int ucol, ch, kind;
        if (cg < 32) { kind = 0; ch = (4 * g) * 64 + cg * 8; ucol = UX + ch; } else if (cg < 40) { kind = 1; ch = 512 + g * 64 + (cg - 32) * 8; ucol = UB + g * 64 + (cg - 32) * 8; } else { kind = 2; ch = 640 + g * 64 + (cg - 40) * 8; ucol = UC + g * 64 + (cg - 40) * 8; }
        float wt[5][8], bias[8];
#pragma unroll
        for (int j = 0; j < 5; ++j) { const f32x4 a = *(const f32x4*)(cw + j * 768 + ch), bq = *(const f32x4*)(cw + j * 768 + ch + 4); wt[j][0] = a.x; wt[j][1] = a.y; wt[j][2] = a.z; wt[j][3] = a.w; wt[j][4] = bq.x; wt[j][5] = bq.y; wt[j][6] = bq.z; wt[j][7] = bq.w; }
        { const f32x4 a = *(const f32x4*)(cb + ch), bq = *(const f32x4*)(cb + ch + 4); bias[0] = a.x; bias[1] = a.y; bias[2] = a.z; bias[3] = a.w; bias[4] = bq.x; bias[5] = bq.y; bias[6] = bq.z; bias[7] = bq.w; }
        u32x4 raw[12];
#pragma unroll
        for (int i = 0; i < 12; ++i) { const int tt = t0 + tb + i - 2; raw[i] = (tt >= 0 && tt < len) ? *(const u32x4*)(U + (size_t)(rowbase + tb + i - 2) * NU + ucol) : (u32x4){0u, 0u, 0u, 0u}; }
#pragma unroll
        for (int i = 0; i < 8; ++i) { float acc[8];
#pragma unroll
            for (int e = 0; e < 8; ++e) acc[e] = bias[e];
#pragma unroll
            for (int j = 0; j < 5; ++j) { const u32x4 rw = raw[i + j];
                acc[0] += bflo(rw.x) * wt[j][0]; acc[1] += bfhi(rw.x) * wt[j][1]; acc[2] += bflo(rw.y) * wt[j][2]; acc[3] += bfhi(rw.y) * wt[j][3];
                acc[4] += bflo(rw.z) * wt[j][4]; acc[5] += bfhi(rw.z) * wt[j][5]; acc[6] += bflo(rw.w) * wt[j][6]; acc[7] += bfhi(rw.w) * wt[j][7]; }
#pragma unroll
            for (int e = 0; e < 8; ++e) acc[e] = silu_f(acc[e]);
            u32x4 o; o.x = cvtpk(acc[0], acc[1]); o.y = cvtpk(acc[2], acc[3]); o.z = cvtpk(acc[4], acc[5]); o.w = cvtpk(acc[6], acc[7]);
            const int t = tb + i; int off;
            if (kind == 0) { const int hl = cg >> 3, p0 = (cg & 7) * 8; off = SD_X + hl * 16384 + (p0 >> 5) * 8192 + t * 64 + (p0 & 31) * 2; }
            else { const int n0 = ((kind == 1) ? (cg - 32) : (cg - 40)) * 8; const int base = (kind == 1) ? SD_B : SD_C;
                if (kind == 1 && B_TR) off = base + (n0 >> 5) * 8192 + t * 64 + (n0 & 31) * 2; else off = base + (n0 >> 3) * 2048 + t * 16; }
            *(LAS u32x4*)(c.lds + off) = o; }
    }
}
__device__ __forceinline__ void ssd_scan_stage(const Ctx& c, int l, int g, int rowbase) {
    const Params& P = *c.P; const float* dtv = (const float*)(c.ws + WS_DT);
    const int tid_l = c.wave * 64 + lane_now();
    const int hl = c.wave >> 1, dir = c.wave & 1, hh = 4 * g + hl, lane = tid_l & 63;
    const float a = -__expf(P.in[I_ALOG][l * 16 + dir * 8 + hh]);
    const float d0 = dtv[(size_t)(rowbase + 2 * lane) * 16 + dir * 8 + hh], d1 = dtv[(size_t)(rowbase + 2 * lane + 1) * 16 + dir * 8 + hh];
    const float x0 = d0 * a, x1 = d1 * a; float ps = x0 + x1, inc = ps;
    if (dir == 0) {
#pragma unroll
        for (int o = 1; o < 64; o <<= 1) { const float v = __shfl_up(inc, o); if (lane >= o) inc += v; }
    } else {
#pragma unroll
        for (int o = 1; o < 64; o <<= 1) { const float v = __shfl_down(inc, o); if (lane + o < 64) inc += v; }
    }
    const float ex = inc - ps;
    float a0, a1;
    if (dir == 0) { a0 = ex + x0; a1 = ex + ps; } else { a1 = ex + x1; a0 = ex + ps; }
    const float total = dir == 0 ? __shfl(inc, 63) : __shfl(inc, 0);
    LAS float* wt = (LAS float*)(c.lds + SD_WT) + hl * 512;
    wt[dir * 128 + 2 * lane] = a0; wt[dir * 128 + 2 * lane + 1] = a1; wt[256 + dir * 128 + 2 * lane] = __logf(d0) - a0; wt[256 + dir * 128 + 2 * lane + 1] = __logf(d1) - a1;
    LAS float* wv = (LAS float*)(c.lds + SD_WV) + (hl * 2 + dir) * 128;
    wv[2 * lane] = __expf(total - a0) * d0; wv[2 * lane + 1] = __expf(total - a1) * d1;
    if (lane == 0) ((LAS float*)(c.lds + SD_MISC))[hl * 2 + dir] = total;
}

__device__ __forceinline__ void ssd_s1_unit(const Ctx& c, int l, int b, int cidx, int g) {
    int t0, len; const int rowbase = chunk_row(b, cidx, t0, len);
    ssd_conv_stage<false, true>(c, l, g, rowbase, t0, len);
    ssd_scan_stage(c, l, g, rowbase);
    __syncthreads();
    const int tid_l = c.wave * 64 + lane_now();
    const int lane = tid_l & 63, hi = lane >> 5, hl = c.wave >> 1, dir = c.wave & 1, hh = 4 * g + hl;
    const LAS unsigned char* Xb = c.lds + SD_X + hl * 16384 + (4 * hi + ((lane & 15) >> 2)) * 64 + ((lane >> 4) & 1) * 32 + (lane & 3) * 8;
    const LAS unsigned char* Bb = c.lds + SD_B + (4 * hi + ((lane & 15) >> 2)) * 64 + ((lane >> 4) & 1) * 32 + (lane & 3) * 8;
    const LAS float* wv = (const LAS float*)(c.lds + SD_WV) + (hl * 2 + dir) * 128;
    f32x16 acc[2][2];
#pragma unroll
    for (int i = 0; i < 2; ++i) { acc[i][0] = zero16(); acc[i][1] = zero16(); }
#pragma unroll 2
    for (int ks = 0; ks < 8; ++ks) {
        const f32x4 w0 = *(const LAS f32x4*)(wv + 16 * ks + 4 * hi), w1 = *(const LAS f32x4*)(wv + 16 * ks + 8 + 4 * hi);
        bf16x8 xa[2], bb[2];
#pragma unroll
        for (int pt = 0; pt < 2; ++pt) { const s16x4 lo = lds_tr(Xb + pt * 8192 + ks * 1024), hi4 = lds_tr(Xb + pt * 8192 + ks * 1024 + 512);
            u32x4 t; t.x = cvtpk(bf2f((unsigned short)lo[0]) * w0.x, bf2f((unsigned short)lo[1]) * w0.y); t.y = cvtpk(bf2f((unsigned short)lo[2]) * w0.z, bf2f((unsigned short)lo[3]) * w0.w);
            t.z = cvtpk(bf2f((unsigned short)hi4[0]) * w1.x, bf2f((unsigned short)hi4[1]) * w1.y); t.w = cvtpk(bf2f((unsigned short)hi4[2]) * w1.z, bf2f((unsigned short)hi4[3]) * w1.w);
            xa[pt] = __builtin_bit_cast(bf16x8, t); }
#pragma unroll
        for (int nt = 0; nt < 2; ++nt) { const s16x4 lo = lds_tr(Bb + nt * 8192 + ks * 1024), hi4 = lds_tr(Bb + nt * 8192 + ks * 1024 + 512);
            bb[nt] = (bf16x8){lo[0], lo[1], lo[2], lo[3], hi4[0], hi4[1], hi4[2], hi4[3]}; }
#pragma unroll
        for (int pt = 0; pt < 2; ++pt)
#pragma unroll
            for (int nt = 0; nt < 2; ++nt) acc[pt][nt] = __builtin_amdgcn_mfma_f32_32x32x16_bf16(xa[pt], bb[nt], acc[pt][nt], 0, 0, 0);
    }
    float* ST = (float*)(c.ws + WS_ST) + ((((size_t)b * NCH + cidx) * 8 + hh) * 2 + dir) * 4096;
#pragma unroll
    for (int pt = 0; pt < 2; ++pt)
#pragma unroll
        for (int nt = 0; nt < 2; ++nt)
#pragma unroll
            for (int r = 0; r < 16; ++r) ST[(32 * pt + crow(r, hi)) * 64 + 32 * nt + (lane & 31)] = acc[pt][nt][r];
    if (lane == 0) ((float*)(c.ws + WS_TOT))[(((size_t)b * NCH + cidx) * 8 + hh) * 2 + dir] = ((const LAS float*)(c.lds + SD_MISC))[hl * 2 + dir];
    __syncthreads();
}

__device__ __forceinline__ int chain_chunk(int dir, int i) { return dir == 0 ? i : (i == 0 ? 1 : (i == 1 ? 0 : NCH + 1 - i)); }
__device__ __forceinline__ void ssd_s2_item(const Ctx& c, int item) {
    const int half = item & 1, chain = item >> 1, dir = chain & 1, hh = (chain >> 1) & 7, b = chain >> 4;
    const int tid_l = c.wave * 64 + lane_now();
    const int p = 32 * half + (tid_l >> 4), n = 4 * (tid_l & 15);
    const float* ST = (const float*)(c.ws + WS_ST); const float* TOT = (const float*)(c.ws + WS_TOT); bf16_t* PV = (bf16_t*)(c.ws + WS_PREV);
    f32x4 carry = {0.f, 0.f, 0.f, 0.f};
#pragma unroll 6
    for (int i = 0; i < NCH; ++i) { const int cidx = chain_chunk(dir, i); const size_t idx = (((size_t)b * NCH + cidx) * 8 + hh) * 2 + dir;
        const f32x4 s = *(const f32x4*)(ST + idx * 4096 + p * 64 + n); const float dec = __expf(TOT[idx]);
        u32x2 o; o.x = cvtpk(carry.x, carry.y); o.y = cvtpk(carry.z, carry.w); *(u32x2*)(PV + idx * 4096 + p * 64 + n) = o;
        carry = carry * dec + s; }
}

__device__ __forceinline__ void ssd_s3_unit(const Ctx& c, int l, int b, int cidx) {
    const Params& P = *c.P; const bf16_t* U = (const bf16_t*)(c.ws + WS_U); bf16_t* O = (bf16_t*)(c.ws + WS_O);
    int t0, len; const int rowbase = chunk_row(b, cidx, t0, len);
    const int tid_l = c.wave * 64 + lane_now();
    const int lane = tid_l & 63, r32 = lane & 31, hi = lane >> 5, hl = c.wave >> 1, qh2 = c.wave & 1;
#pragma unroll
    for (int g = 0; g < 2; ++g) {
        const int hh = 4 * g + hl;
        MK_TS(c, 1, 0); ssd_conv_stage<true, false>(c, l, g, rowbase, t0, len); MK_TS(c, 1, 1);
        MK_TS(c, 2, 0); ssd_scan_stage(c, l, g, rowbase);
        __syncthreads(); MK_TS(c, 2, 1);
        const LAS float* wt = (const LAS float*)(c.lds + SD_WT) + hl * 512;
        const LAS unsigned char* Xb = c.lds + SD_X + hl * 16384 + (4 * hi + ((lane & 15) >> 2)) * 64 + ((lane >> 4) & 1) * 32 + (lane & 3) * 8;
        const float dsk = P.in[I_SSDD][l * 8 + hh];
#pragma unroll
        for (int qt = 0; qt < 2; ++qt) {
            const int qtg = 2 * qh2 + qt, q = 32 * qtg + r32;
            const LAS unsigned char* cfp = c.lds + SD_C + hi * 2048 + q * 16;
            const float afq = wt[q], abq = wt[128 + q], lwfq = wt[256 + q], lwbq = wt[384 + q];
            f32x16 y[2]; y[0] = zero16(); y[1] = zero16();
            MK_TS(c, 3, 0);
#pragma unroll 1
            for (int jt = 0; jt < 4; ++jt) {
                f32x16 gt = zero16();
#pragma unroll
                for (int s = 0; s < 4; ++s) { const bf16x8 bfr = *(const LAS bf16x8*)(c.lds + SD_B + s * 4096 + hi * 2048 + (32 * jt + r32) * 16);
                    gt = __builtin_amdgcn_mfma_f32_32x32x16_bf16(bfr, *(const LAS bf16x8*)(cfp + s * 4096), gt, 0, 0, 0); }
                if (jt < qtg) {
#pragma unroll
                    for (int r = 0; r < 16; ++r) gt[r] *= __expf(afq + wt[256 + 32 * jt + crow(r, hi)]);
                } else if (jt > qtg) {
#pragma unroll
                    for (int r = 0; r < 16; ++r) gt[r] *= __expf(abq + wt[384 + 32 * jt + crow(r, hi)]);
                } else {
#pragma unroll
                    for (int r = 0; r < 16; ++r) { const int j = 32 * jt + crow(r, hi);
                        const float wv = j < q ? __expf(afq + wt[256 + j]) : (j > q ? __expf(abq + wt[384 + j]) : __expf(afq + lwfq) + __expf(abq + lwbq));
                        gt[r] *= wv; }
                }
                u32x4 m0 = {cvtpk(gt[0], gt[1]), cvtpk(gt[2], gt[3]), cvtpk(gt[4], gt[5]), cvtpk(gt[6], gt[7])}, m1 = {cvtpk(gt[8], gt[9]), cvtpk(gt[10], gt[11]), cvtpk(gt[12], gt[13]), cvtpk(gt[14], gt[15])};
                const bf16x8 pa0 = __builtin_bit_cast(bf16x8, m0), pa1 = __builtin_bit_cast(bf16x8, m1);
#pragma unroll
                for (int pt = 0; pt < 2; ++pt)
#pragma unroll
                    for (int s2 = 0; s2 < 2; ++s2) { const s16x4 lo = lds_tr(Xb + pt * 8192 + (2 * jt + s2) * 1024), h4 = lds_tr(Xb + pt * 8192 + (2 * jt + s2) * 1024 + 512);
                        const bf16x8 xa = {lo[0], lo[1], lo[2], lo[3], h4[0], h4[1], h4[2], h4[3]};
                        y[pt] = __builtin_amdgcn_mfma_f32_32x32x16_bf16(xa, s2 == 0 ? pa0 : pa1, y[pt], 0, 0, 0); }
            }
            MK_TS(c, 3, 1); MK_TS(c, 4, 0);
            const int ql = 64 * qh2 + 32 * qt + r32; const bf16_t* zrow = U + (size_t)(rowbase + ql) * NU + UZ + hh * 64 + 4 * hi;
#pragma unroll 1
            for (int dir = 0; dir < 2; ++dir) { const bf16_t* PV = (const bf16_t*)(c.ws + WS_PREV) + ((((size_t)b * NCH + cidx) * 8 + hh) * 2 + dir) * 4096;
                bf16x8 pf[2][4];
#pragma unroll
                for (int pt = 0; pt < 2; ++pt)
#pragma unroll
                    for (int s = 0; s < 4; ++s) pf[pt][s] = *(const bf16x8*)(PV + (32 * pt + r32) * 64 + 16 * s + 8 * hi);
                const float eq = __expf(dir == 0 ? afq : abq);
#pragma unroll
                for (int pt = 0; pt < 2; ++pt) { f32x16 tmp = zero16();
#pragma unroll
                    for (int s = 0; s < 4; ++s) tmp = __builtin_amdgcn_mfma_f32_32x32x16_bf16(pf[pt][s], *(const LAS bf16x8*)(cfp + s * 4096), tmp, 0, 0, 0);
#pragma unroll
                    for (int r = 0; r < 16; ++r) y[pt][r] += eq * tmp[r]; }
            }
            MK_TS(c, 4, 1); MK_TS(c, 5, 0);
            float ssq = 0.f;
            {
#pragma unroll
              for (int pt = 0; pt < 2; ++pt)
#pragma unroll
                for (int g4 = 0; g4 < 4; ++g4) { const int p0 = 32 * pt + 8 * g4 + 4 * hi;
                    const u32x2 zz_ = *(const u32x2*)(zrow + 32 * pt + 8 * g4);
                    const u32x2 xx = *(const LAS u32x2*)(c.lds + SD_X + hl * 16384 + (p0 >> 5) * 8192 + ql * 64 + (p0 & 31) * 2);
                    float v0 = (y[pt][4 * g4] + dsk * bflo(xx.x)) * silu_f(bflo(zz_.x)), v1 = (y[pt][4 * g4 + 1] + dsk * bfhi(xx.x)) * silu_f(bfhi(zz_.x));
                    float v2 = (y[pt][4 * g4 + 2] + dsk * bflo(xx.y)) * silu_f(bflo(zz_.y)), v3 = (y[pt][4 * g4 + 3] + dsk * bfhi(xx.y)) * silu_f(bfhi(zz_.y));
                    ssq += (v0 * v0 + v1 * v1) + (v2 * v2 + v3 * v3);
                    u32x2 o; o.x = cvtpk(v0, v1); o.y = cvtpk(v2, v3); *(u32x2*)(O + (size_t)(rowbase + ql) * 1024 + 256 + hh * 64 + 4 * hi + 32 * pt + 8 * g4) = o; }
              ssq += __shfl_xor(ssq, 32); if (hi == 0) ((LAS float*)(c.lds + SD_SSQ))[(g * 4 + hl) * 128 + ql] = ssq; }
        }
        MK_TS(c, 5, 1);
        __syncthreads();
    }
    MK_TS(c, 6, 0);
    asm volatile("s_waitcnt vmcnt(0)" ::: "memory");
#pragma unroll
    for (int qt = 0; qt < 2; ++qt) { const int q = 64 * qh2 + 32 * qt + r32; float sq = 0.f;
#pragma unroll
        for (int s8 = 0; s8 < 8; ++s8) sq += ((const LAS float*)(c.lds + SD_SSQ))[s8 * 128 + q];
        const float rstd = __builtin_amdgcn_rsqf(sq * (1.0f / 512.0f) + 1e-6f);
#pragma unroll
        for (int g = 0; g < 2; ++g) { const int hh = 4 * g + hl; const float* ng = P.in[I_SSDG] + l * 512 + hh * 64 + 4 * hi; bf16_t* orow = O + (size_t)(rowbase + q) * 1024 + 256 + hh * 64 + 4 * hi;
            u32x2 v[2][4];
#pragma unroll
            for (int pt = 0; pt < 2; ++pt)
#pragma unroll
                for (int g4 = 0; g4 < 4; ++g4) v[pt][g4] = *(const u32x2*)(orow + 32 * pt + 8 * g4);
#pragma unroll
            for (int pt = 0; pt < 2; ++pt)
#pragma unroll
                for (int g4 = 0; g4 < 4; ++g4) { const f32x4 gg = *(const f32x4*)(ng + 32 * pt + 8 * g4); const u32x2 vv = v[pt][g4];
                    u32x2 o; o.x = cvtpk(bflo(vv.x) * rstd * gg.x, bfhi(vv.x) * rstd * gg.y); o.y = cvtpk(bflo(vv.y) * rstd * gg.z, bfhi(vv.y) * rstd * gg.w);
                    *(u32x2*)(orow + 32 * pt + 8 * g4) = o; } } }
    __syncthreads(); MK_TS(c, 6, 1);
}
}
namespace mk {
constexpr int LC_HIST = 16, LC_BASE = 48, LC_OFF = 80, LC_NT = 120;

__device__ __forceinline__ void router_table_fill(const Ctx& c, int l) {
    const Params& P = *c.P; const int tid_l = c.wave * 64 + lane_now(); LAS f32x4* rw = (LAS f32x4*)c.lds;
    const float* wg = P.in[I_WRG] + (size_t)l * 1024 * 4; const float* we = P.in[I_WRE] + (size_t)l * 1024 * 32;
    __syncthreads();
    for (int i = tid_l; i < 1024 * 9; i += NTHREADS) { const int k = i / 9, q = i % 9; const f32x4 v = q == 0 ? *(const f32x4*)(wg + k * 4) : *(const f32x4*)(we + k * 32 + (q - 1) * 4); rw[q * 1024 + k] = v; }
}
__device__ __forceinline__ void dt_table_fill(const Ctx& c, int l_next) {
    const int tid_l = c.wave * 64 + lane_now(); const float* wdt_g = (const float*)(c.ws + WS_WDT) + (size_t)l_next * 16 * 1024;
    __syncthreads();
    for (int i = tid_l; i < 16 * 256; i += NTHREADS) ((LAS f32x4*)c.lds)[i] = ((const f32x4*)wdt_g)[i];
}
__device__ __forceinline__ void phase_router(const Ctx& c, int l, int nrows, int cnt_slot) {
    const Params& P = *c.P; const float* xw = (const float*)(c.ws + WS_XW); bf16_t* H = (bf16_t*)(c.ws + WS_H);
    const float* mods = (const float*)(c.ws + WS_MODS) + (size_t)l * 9 * 6144;
    const int tid_l = c.wave * 64 + lane_now(); const int lane = tid_l & 63;
    volatile LAS unsigned* lctl = (volatile LAS unsigned*)(c.lds + LDS_CTL_OFF);
    LAS f32x4* rw = (LAS f32x4*)c.lds;
    if (tid_l < 32) lctl[LC_HIST + tid_l] = 0u;
    __syncthreads();
    const float* gf = P.in[I_GFFN] + l * 1024;
    int* SEL = (int*)(c.ws + WS_ROUTE + RT_SEL); int* POS = (int*)(c.ws + WS_ROUTE + RT_POS); float* RW = (float*)(c.ws + WS_ROUTE + RT_W);
    const int gw = c.bid * NWAVES + c.wave, NGW = c.G * NWAVES;
    int my_e0 = 0, my_e1 = 0, my_p0 = 0, my_p1 = 0, nmine = 0;
    for (int row = gw; row < nrows; row += NGW, ++nmine) {
        const int bb = row < NLAT ? row >> 11 : 8; const float* shift = mods + bb * 6144 + 3 * 1024 + lane; const float* scale = mods + bb * 6144 + 4 * 1024 + lane;
        const float* xr = xw + (size_t)row * 1024 + lane; float v[16]; float ss = 0.f;
#pragma unroll
        for (int m = 0; m < 16; ++m) { v[m] = xr[64 * m]; ss += v[m] * v[m]; }
        const float rstd = __builtin_amdgcn_rsqf(wave_sum(ss) * (1.0f / 1024.0f) + 1e-6f);
        bf16_t* hr = H + (size_t)row * 1024 + lane;
#pragma unroll
        for (int m = 0; m < 16; ++m) { v[m] = (v[m] * rstd) * gf[lane + 64 * m] * (scale[64 * m] + 1.0f) + shift[64 * m]; hr[64 * m] = (bf16_t)(cvtpk(v[m], v[m]) & 0xffffu); }
        float acc[36];
#pragma unroll
        for (int q = 0; q < 36; ++q) acc[q] = 0.f;
#pragma unroll
        for (int m = 0; m < 16; ++m) { const float hv = v[m];
#pragma unroll
            for (int q = 0; q < 9; ++q) { const f32x4 w4 = rw[q * 1024 + lane + 64 * m]; acc[4 * q] += hv * w4.x; acc[4 * q + 1] += hv * w4.y; acc[4 * q + 2] += hv * w4.z; acc[4 * q + 3] += hv * w4.w; }
            if (m & 1) __builtin_amdgcn_sched_barrier(0); }
#pragma unroll
        for (int q = 0; q < 4; ++q) acc[q] = wave_sum(acc[q]) + P.in[I_BRG][l * 4 + q];
        float ea[16], eb[16];
#pragma unroll
        for (int q = 0; q < 16; ++q) { ea[q] = acc[4 + q]; eb[q] = acc[20 + q]; }
        const int jd_l = ((lane >> 5) & 1) * 8 + ((lane >> 4) & 1) * 4 + ((lane >> 3) & 1) * 2 + ((lane >> 2) & 1);
        const float ta = reduce16_transposed(ea, lane) + P.in[I_BRE][l * 32 + jd_l], tb = reduce16_transposed(eb, lane) + P.in[I_BRE][l * 32 + 16 + jd_l];
        int gi = 0; float gm = acc[0];
#pragma unroll
        for (int j = 1; j < 4; ++j) if (acc[j] > gm) { gm = acc[j]; gi = j; }
        float gs = 0.f;
#pragma unroll
        for (int j = 0; j < 4; ++j) gs += __expf(acc[j] - gm);
        const float gwt = 1.0f / gs;
        float el[8];
#pragma unroll
        for (int j = 0; j < 8; ++j) { const int jd = (gi & 1) * 8 + j; const int src = ((jd >> 3) & 1) * 32 + ((jd >> 2) & 1) * 16 + ((jd >> 1) & 1) * 8 + (jd & 1) * 4;
            const float fa = __shfl(ta, src), fb = __shfl(tb, src); el[j] = gi >= 2 ? fb : fa; }
        int i0 = 0; float v0 = el[0];
#pragma unroll
        for (int j = 1; j < 8; ++j) if (el[j] > v0) { v0 = el[j]; i0 = j; }
        int i1 = -1; float v1 = 0.f;
#pragma unroll
        for (int j = 0; j < 8; ++j) if (j != i0 && (i1 < 0 || el[j] > v1)) { v1 = el[j]; i1 = j; }
        const float e1 = __expf(v1 - v0); const float w0 = gwt / (1.0f + e1), w1 = gwt * e1 / (1.0f + e1);
        const int ex0 = gi * 8 + i0, ex1 = gi * 8 + i1;
        int lp0 = 0, lp1 = 0;
        if (lane == 0) { lp0 = (int)__hip_atomic_fetch_add((LAS unsigned*)(c.lds + LDS_CTL_OFF) + LC_HIST + ex0, 1u, __ATOMIC_RELAXED, __HIP_MEMORY_SCOPE_WORKGROUP);
                         lp1 = (int)__hip_atomic_fetch_add((LAS unsigned*)(c.lds + LDS_CTL_OFF) + LC_HIST + ex1, 1u, __ATOMIC_RELAXED, __HIP_MEMORY_SCOPE_WORKGROUP);
                         SEL[row * 2] = ex0; SEL[row * 2 + 1] = ex1; RW[row * 2] = w0; RW[row * 2 + 1] = w1; }
        lp0 = __shfl(lp0, 0); lp1 = __shfl(lp1, 0);
        if (lane == nmine) { my_e0 = ex0; my_e1 = ex1; my_p0 = lp0; my_p1 = lp1; }
    }
    __syncthreads();
    unsigned* ctlw = (unsigned*)(c.ws + WS_CTL);
    unsigned* cnt = ctlw + CW_CNT + 64 * cnt_slot; unsigned* pool = ctlw + CW_POOL + 64 * cnt_slot; unsigned* tof = ctlw + CW_TOF + 8192 * cnt_slot;
    int* tile_e = (int*)(c.ws + WS_ROUTE + RT_TILE_E);
    if (tid_l < 32) { const unsigned h = lctl[LC_HIST + tid_l]; unsigned base = 0;
        if (h) { base = __hip_atomic_fetch_add(cnt + tid_l, h, __ATOMIC_RELAXED, __HIP_MEMORY_SCOPE_AGENT);
            for (unsigned j = (base + 255u) >> 8; (j << 8) < base + h; ++j) { const unsigned t = __hip_atomic_fetch_add(pool, 1u, __ATOMIC_RELAXED, __HIP_MEMORY_SCOPE_AGENT);
                tile_e[t] = tid_l; __hip_atomic_store(tof + tid_l * 144 + j, t + 1u, __ATOMIC_RELAXED, __HIP_MEMORY_SCOPE_AGENT); } }
        lctl[LC_BASE + tid_l] = base; }
    __syncthreads();
    int* SLOT = (int*)(c.ws + WS_ROUTE + RT_SLOT); bf16_t* HS = (bf16_t*)(c.ws + WS_U);
    int ms0 = 0, ms1 = 0;
    if (lane < nmine) { const int row = gw + lane * NGW;
        const unsigned p0 = lctl[LC_BASE + my_e0] + (unsigned)my_p0, p1 = lctl[LC_BASE + my_e1] + (unsigned)my_p1;
        unsigned t0 = 0, t1 = 0;
        for (unsigned sp = 0; sp < (1u << 22); ++sp) { if (!t0) t0 = __hip_atomic_load(tof + my_e0 * 144 + (p0 >> 8), __ATOMIC_RELAXED, __HIP_MEMORY_SCOPE_AGENT); if (!t1) t1 = __hip_atomic_load(tof + my_e1 * 144 + (p1 >> 8), __ATOMIC_RELAXED, __HIP_MEMORY_SCOPE_AGENT);
            if (t0 && t1) break; __builtin_amdgcn_s_sleep(1); }
        ms0 = (int)(((t0 ? t0 : 1u) - 1u) * 256u + (p0 & 255u)); ms1 = (int)(((t1 ? t1 : 1u) - 1u) * 256u + (p1 & 255u));
        SLOT[row * 2] = ms0; SLOT[row * 2 + 1] = ms1; }
    asm volatile("s_waitcnt vmcnt(0)" ::: "memory");
    for (int i = 0; i < nmine; ++i) { const int row = gw + i * NGW; const int s0 = __shfl(ms0, i), s1 = __shfl(ms1, i);
        const u32x4* src = (const u32x4*)(H + (size_t)row * 1024) + lane; const u32x4 a = src[0], bq = src[64];
        u32x4* d0 = (u32x4*)(HS + (size_t)s0 * 1024) + lane; u32x4* d1 = (u32x4*)(HS + (size_t)s1 * 1024) + lane;
        d0[0] = a; d0[64] = bq; d1[0] = a; d1[64] = bq; }
    __syncthreads();
}

__device__ __forceinline__ void phase_sort(const Ctx& c, int l, int nrows) {
    const int tid_l = c.wave * 64 + lane_now(); const int lane = tid_l & 63;
    volatile LAS unsigned* lctl = (volatile LAS unsigned*)(c.lds + LDS_CTL_OFF);
    const unsigned* cnt = (const unsigned*)(c.ws + WS_CTL) + CW_CNT + 64 * l;
    int* tile_e = (int*)(c.ws + WS_ROUTE + RT_TILE_E); int* ntl = (int*)(c.ws + WS_ROUTE + RT_NTILES);
    if (tid_l == 0) { unsigned off = 0;
#pragma unroll 1
        for (int e = 0; e < 32; ++e) { const unsigned n = __hip_atomic_load(cnt + e, __ATOMIC_RELAXED, __HIP_MEMORY_SCOPE_AGENT); lctl[LC_OFF + e] = off; const unsigned nt = (n + 255u) >> 8;
            if (c.bid == 0) {
#pragma unroll 1
                for (unsigned t = 0; t < nt; ++t) tile_e[(off >> 8) + t] = e; }
            off += nt << 8; }
        if (c.bid == 0) ntl[0] = (int)(off >> 8); }
    __syncthreads();
    const int* SEL = (const int*)(c.ws + WS_ROUTE + RT_SEL); const int* POS = (const int*)(c.ws + WS_ROUTE + RT_POS); int* SLOT = (int*)(c.ws + WS_ROUTE + RT_SLOT);
    const bf16_t* H = (const bf16_t*)(c.ws + WS_H); bf16_t* HS = (bf16_t*)(c.ws + WS_U);
    const int gw = c.bid * NWAVES + c.wave, NGW = c.G * NWAVES;
    for (int row = gw; row < nrows; row += NGW) {
        const int s0 = (int)lctl[LC_OFF + SEL[row * 2]] + POS[row * 2], s1 = (int)lctl[LC_OFF + SEL[row * 2 + 1]] + POS[row * 2 + 1];
        if (lane == 0) { SLOT[row * 2] = s0; SLOT[row * 2 + 1] = s1; }
        const u32x4* src = (const u32x4*)(H + (size_t)row * 1024) + lane; const u32x4 a = src[0], b = src[64];
        u32x4* d0 = (u32x4*)(HS + (size_t)s0 * 1024) + lane; u32x4* d1 = (u32x4*)(HS + (size_t)s1 * 1024) + lane;
        d0[0] = a; d0[64] = b; d1[0] = a; d1[64] = b;
    }
    __syncthreads();
}

struct CombRow { f32x4 x[4]; u32x2 a[4], b[4]; float w0, w1; int bb; };
__device__ __forceinline__ void comb_load(CombRow& r, int row, int s0, int s1, float w0, float w1, const float* xw, const bf16_t* OS, int lane) {
    r.w0 = w0; r.w1 = w1; r.bb = row < NLAT ? row >> 11 : 8;
#pragma unroll
    for (int j = 0; j < 4; ++j) { r.x[j] = ((const f32x4*)(xw + (size_t)row * 1024))[lane + 64 * j]; r.a[j] = __builtin_nontemporal_load((const u32x2*)(OS + (size_t)s0 * 1024) + lane + 64 * j); r.b[j] = __builtin_nontemporal_load((const u32x2*)(OS + (size_t)s1 * 1024) + lane + 64 * j); }
}
__device__ __forceinline__ void comb_finish(const Ctx& c, CombRow& r, int row, int l, bool last, bool store_x, const LAS float* wdt, int lane) {
    const Params& P = *c.P; float* xw = (float*)(c.ws + WS_XW); const float* mods = (const float*)(c.ws + WS_MODS) + (size_t)l * 9 * 6144;
    const float* gate = mods + r.bb * 6144 + 5 * 1024; f32x4 v[4]; float ss = 0.f;
#pragma unroll
    for (int j = 0; j < 4; ++j) { const f32x4 gg = ((const f32x4*)gate)[lane + 64 * j]; f32x4 x = r.x[j]; const u32x2 a = r.a[j], bq = r.b[j]; const float w0 = r.w0, w1 = r.w1;
        x.x += gg.x * (w0 * bflo(a.x) + w1 * bflo(bq.x)); x.y += gg.y * (w0 * bfhi(a.x) + w1 * bfhi(bq.x)); x.z += gg.z * (w0 * bflo(a.y) + w1 * bflo(bq.y)); x.w += gg.w * (w0 * bfhi(a.y) + w1 * bfhi(bq.y));
        v[j] = x; ss += (x.x * x.x + x.y * x.y) + (x.z * x.z + x.w * x.w); if (!last && store_x) ((f32x4*)(xw + (size_t)row * 1024))[lane + 64 * j] = x; }
    const float rstd = __builtin_amdgcn_rsqf(wave_sum(ss) * (1.0f / 1024.0f) + 1e-6f);
    if (last) {
#pragma unroll
        for (int j = 0; j < 4; ++j) { const f32x4 gg = ((const f32x4*)P.in[I_GFIN])[lane + 64 * j]; ((f32x4*)(P.out + (size_t)row * 1024))[lane + 64 * j] = (v[j] * rstd) * gg; }
    } else {
        const float* modn = (const float*)(c.ws + WS_MODS) + (size_t)(l + 1) * 9 * 6144; bf16_t* H = (bf16_t*)(c.ws + WS_H); float* dtv = (float*)(c.ws + WS_DT);
        const float* g = P.in[I_GMIX] + (l + 1) * 1024; const float* shift = modn + r.bb * 6144; const float* scale = modn + r.bb * 6144 + 1024;
#pragma unroll
        for (int j = 0; j < 4; ++j) { const f32x4 gg = ((const f32x4*)g)[lane + 64 * j], sh = ((const f32x4*)shift)[lane + 64 * j], sl = ((const f32x4*)scale)[lane + 64 * j];
            v[j] = (v[j] * rstd) * gg * (sl + 1.0f) + sh;
            u32x2 o; o.x = cvtpk(v[j].x, v[j].y); o.y = cvtpk(v[j].z, v[j].w); ((u32x2*)(H + (size_t)row * 1024))[lane + 64 * j] = o; }
        float pa[16];
#pragma unroll
        for (int jd = 0; jd < 16; ++jd) { float a = 0.f;
#pragma unroll
            for (int j = 0; j < 4; ++j) { const f32x4 w = ((const LAS f32x4*)(wdt + jd * 1024))[lane + 64 * j]; a += (v[j].x * w.x + v[j].y * w.y) + (v[j].z * w.z + v[j].w * w.w); }
            pa[jd] = a; if ((jd & 3) == 3) __builtin_amdgcn_sched_barrier(0); }
        const float tot = reduce16_transposed(pa, lane); const int jd_l = ((lane >> 5) & 1) * 8 + ((lane >> 4) & 1) * 4 + ((lane >> 3) & 1) * 2 + ((lane >> 2) & 1);
        if ((lane & 3) == 0) dtv[(size_t)row * 16 + jd_l] = softplus_f(tot + P.in[I_DTB][(l + 1) * 16 + jd_l]);
    }
}
__device__ __forceinline__ void phase_combine(const Ctx& c, int l, int nrows, bool store_x) {
    const float* xw = (const float*)(c.ws + WS_XW); const bf16_t* OS = (const bf16_t*)(c.ws + WS_U);
    const int* SLOT = (const int*)(c.ws + WS_ROUTE + RT_SLOT); const float* RW = (const float*)(c.ws + WS_ROUTE + RT_W);
    const int tid_l = c.wave * 64 + lane_now(); const int lane = tid_l & 63;
    const int gw = c.bid * NWAVES + c.wave, NGW = c.G * NWAVES;
    const bool last = (l == DEPTH - 1);
    LAS float* wdt = (LAS float*)c.lds;
    __syncthreads();
    int ms0 = 0, ms1 = 0; float mw0 = 0.f, mw1 = 0.f;
    { const int myrow = gw + lane * NGW; if (myrow < nrows) { ms0 = SLOT[myrow * 2]; ms1 = SLOT[myrow * 2 + 1]; mw0 = RW[myrow * 2]; mw1 = RW[myrow * 2 + 1]; } }
    int row = gw, i = 0;
    for (; row + NGW < nrows; row += 2 * NGW, i += 2) {
        CombRow r0, r1;
        comb_load(r0, row, __shfl(ms0, i), __shfl(ms1, i), __shfl(mw0, i), __shfl(mw1, i), xw, OS, lane);
        comb_load(r1, row + NGW, __shfl(ms0, i + 1), __shfl(ms1, i + 1), __shfl(mw0, i + 1), __shfl(mw1, i + 1), xw, OS, lane);
        comb_finish(c, r0, row, l, last, store_x, wdt, lane); comb_finish(c, r1, row + NGW, l, last, store_x, wdt, lane);
    }
    if (row < nrows) { CombRow r0; comb_load(r0, row, __shfl(ms0, i), __shfl(ms1, i), __shfl(mw0, i), __shfl(mw1, i), xw, OS, lane); comb_finish(c, r0, row, l, last, store_x, wdt, lane); }
}
}
namespace mk {
constexpr int NPH = 10, PH_TOTAL = 2 + DEPTH * NPH;
__global__ void __launch_bounds__(NTHREADS, 2) mk_fwd(Params P, int ph_lo, int ph_hi) {
    extern __shared__ __attribute__((aligned(16))) unsigned char lds_raw[];
    Ctx c0; c0.lds = (LAS unsigned char*)lds_raw; c0.wave = __builtin_amdgcn_readfirstlane((int)threadIdx.x >> 6); c0.G = gridDim.x; c0.bid = blockIdx.x; c0.P = &P; c0.ws = P.ws;
    volatile LAS unsigned* lctl = (volatile LAS unsigned*)(c0.lds + LDS_CTL_OFF);
    if (threadIdx.x < 256) lctl[threadIdx.x] = 0u;
    __syncthreads();
    unsigned* ctl = (unsigned*)(c0.ws + WS_CTL);
    XcdBarrier bar; bar.bar = ctl + CW_BAR; bar.x = 0; bar.st = lctl;
    const bool one_launch = (ph_hi - ph_lo) > 1;
    if (one_launch) bar = xcd_barrier_post(ctl + CW_BAR, lctl);
#ifndef MK_DUP
#define MK_DUP -1
#endif
#define NREP(k) ((MK_DUP >= 0 && (((k) < 2) ? (k) == MK_DUP : (((k) - 2) % NPH) + 2 == MK_DUP)) ? 2 : 1)
#define PH(k) if (ph_lo <= (k) && (k) < ph_hi) for (int rep_ = 0; rep_ < NREP(k); ++rep_, body_end(k))
#define DUMMY(k) (NREP(k) == 2 && rep_ == 0)
#ifndef MK_STAMP
#define MK_STAMP -1
#endif
#ifdef MK_SUB
#define defined_MK_SUB 1
#else
#define defined_MK_SUB 0
#endif
    unsigned long long t_prev = 0ull, t_acc = 0ull; if (MK_STAMP >= 0) t_prev = __builtin_amdgcn_s_memrealtime();
    auto body_end = [&](int k) { if (MK_STAMP >= 100) { asm volatile("s_waitcnt vmcnt(0) lgkmcnt(0)" ::: "memory"); const unsigned long long now_ = __builtin_amdgcn_s_memrealtime(); if ((((k) < 2) ? (k) : (((k) - 2) % NPH) + 2) == (MK_STAMP % 100)) t_acc += now_ - t_prev; } };
#define PTYPE(k) (((k) < 2) ? (k) : (((k) - 2) % NPH) + 2)
#define SEAM(k) do { if (ph_lo <= (k) && (k) + 1 < ph_hi) { xcd_barrier(bar); if (MK_DUP == 100) xcd_barrier(bar); } \
    if (MK_STAMP >= 0) { const unsigned long long now_ = __builtin_amdgcn_s_memrealtime(); if (MK_STAMP < 100 && (PTYPE(k) == MK_STAMP || MK_STAMP == 99)) t_acc += now_ - t_prev; t_prev = now_; } } while (0)
    PH(0) { const Ctx c = fresh(c0); phase_p0a(c); } SEAM(0);
    PH(1) { const Ctx c = fresh(c0); phase_norm1(c, 0, c.P->in[I_X], c.P->in[I_CTX]); } SEAM(1);
    for (int l = 0; l < DEPTH; ++l) {
        const int pb = 2 + l * NPH; const bool need_ctx = l < DEPTH - 1;
        PH(pb + 0) { const Ctx c = fresh(c0);
            pg8::Gemm g{(const pg8::bf16_t*)(c.ws + WS_H), (const pg8::bf16_t*)(c.ws + WS_BT_IN) + (size_t)l * NU * 1024, NT, NU, 1024};
            pg8::StaticOrder So; So.init(NT, NU, c.G, c.bid);
            EpiInProj E{(bf16_t*)(c.ws + WS_U), (const f32x2*)(c.ws + WS_ROPE)};
            pg8::gemm_phase<EpiInProj, pg8::StaticOrder, false>((PG8_LAS unsigned char*)c.lds, g, So, E, nullptr, c.wave);
        } SEAM(pb + 0);
        PH(pb + 1) { const Ctx c = fresh(c0);
            for (int i = c.bid; i < 288 + 256; i += c.G) {
                if (i < 288) { const int b = i / 36, rem = i % 36; ssd_s1_unit(c, l, b, rem >> 1, rem & 1); }
                else { const int k = i - 288; attn_unit<0>(c, l, k >> 5, (k & 31) >> 1, k & 1); } }
        } SEAM(pb + 1);
        PH(pb + 2) { const Ctx c = fresh(c0);
            for (int i = c.bid; i < 256; i += c.G) ssd_s2_item(c, i);
        } SEAM(pb + 2);
        PH(pb + 3) { const Ctx c = fresh(c0);
            const int ns3 = need_ctx ? 144 : 128; const int nrest = 256 + (need_ctx ? 64 : 0);
            if (c.bid < ns3) { if (need_ctx) ssd_s3_unit(c, l, c.bid / 18, c.bid % 18); else ssd_s3_unit(c, l, c.bid >> 4, 2 + (c.bid & 15)); }
            else if (c.G > ns3) {
                for (int k = c.bid - ns3; k < nrest; k += c.G - ns3) {
                    if (k < 256) attn_unit<1>(c, l, k >> 5, (k & 31) >> 2, k & 3);
                    else { const int k2 = k - 256; attn_unit<2>(c, l, k2 >> 3, k2 & 7, 0); } } }
        } SEAM(pb + 3);
        PH(pb + 4) { const Ctx c = fresh(c0);
            pg8::Gemm g{(const pg8::bf16_t*)(c.ws + WS_O), (const pg8::bf16_t*)(c.ws + WS_BT_OUT) + (size_t)l * 1024 * 1024, NLAT, 1024, 1024};
            pg8::StaticOrder So; So.init(NLAT, 1024, c.G, c.bid);
            float* xw = (float*)(c.ws + WS_XW); const float* xlat = l == 0 ? c.P->in[I_X] : xw; const float* xctx = l == 0 ? c.P->in[I_CTX] : xw + (size_t)NLAT * 1024;
            EpiOutProj E{xlat, xctx, DUMMY(pb + 4) ? (float*)(c.ws + WS_U) : xw, (const float*)(c.ws + WS_MODS) + (size_t)l * 9 * 6144};
            pg8::gemm_phase<EpiOutProj, pg8::StaticOrder, false>((PG8_LAS unsigned char*)c.lds, g, So, E, nullptr, c.wave);
            if (need_ctx && !DUMMY(pb + 4)) for (int t = c.bid; t < 256; t += c.G) ctx_outproj_tile(c, l, t);
            router_table_fill(c, l);
        } SEAM(pb + 4);
        const int nrows = need_ctx ? NT : NLAT;
        PH(pb + 5) { const Ctx c = fresh(c0); phase_router(c, l, nrows, DUMMY(pb + 5) ? l + 4 : l); } SEAM(pb + 5);
        PH(pb + 7) { const Ctx c = fresh(c0);
            const int ntiles = __builtin_amdgcn_readfirstlane((int)__hip_atomic_load((const unsigned*)(c.ws + WS_CTL) + CW_POOL + 64 * l, __ATOMIC_RELAXED, __HIP_MEMORY_SCOPE_AGENT));
            pg8::Gemm g{(const pg8::bf16_t*)(c.ws + WS_U), (const pg8::bf16_t*)(c.ws + WS_BT_GU) + (size_t)l * 32 * 512 * 1024, ntiles * 256, 512, 1024};
            ExpertOrder<2> So{(const int*)(c.ws + WS_ROUTE + RT_TILE_E), ntiles, c.G, c.bid};
            EpiGateUp E{(bf16_t*)(c.ws + WS_HID)};
            pg8::gemm_phase<EpiGateUp, ExpertOrder<2>, false>((PG8_LAS unsigned char*)c.lds, g, So, E, nullptr, c.wave);
        } SEAM(pb + 7);
        PH(pb + 8) { const Ctx c = fresh(c0);
            const int ntiles = __builtin_amdgcn_readfirstlane((int)__hip_atomic_load((const unsigned*)(c.ws + WS_CTL) + CW_POOL + 64 * l, __ATOMIC_RELAXED, __HIP_MEMORY_SCOPE_AGENT));
            pg8::Gemm g{(const pg8::bf16_t*)(c.ws + WS_HID), (const pg8::bf16_t*)(c.ws + WS_BT_DN) + (size_t)l * 32 * 1024 * 256, ntiles * 256, 1024, 256};
            ExpertOrder<4> So{(const int*)(c.ws + WS_ROUTE + RT_TILE_E), ntiles, c.G, c.bid};
            EpiDown E{(bf16_t*)(c.ws + WS_U)};
            pg8::gemm_phase<EpiDown, ExpertOrder<4>, false>((PG8_LAS unsigned char*)c.lds, g, So, E, nullptr, c.wave);
            if (l + 1 < DEPTH) dt_table_fill(c, l + 1);
        } SEAM(pb + 8);
        PH(pb + 9) { const Ctx c = fresh(c0); phase_combine(c, l, nrows, !DUMMY(pb + 9)); } SEAM(pb + 9);
    }
#ifdef MK_SUB
    if (c0.bid == 0) { __syncthreads(); t_acc = *(volatile LAS unsigned long long*)(c0.lds + LDS_CTL_OFF + 512 + 8); }
#endif
    if ((MK_STAMP >= 0 || defined_MK_SUB) && c0.bid == (MK_STAMP >= 200 ? (int)gridDim.x - 1 : 0)) { const unsigned long long t0 = __builtin_amdgcn_s_memrealtime(); while (__builtin_amdgcn_s_memrealtime() - t0 < t_acc) __builtin_amdgcn_s_sleep(8); }
#undef PH
#undef SEAM
}

static int g_grid = 0;
static void mk_setup() {
    if (g_grid) return;
    int dev = 0, cus = 0; hipGetDevice(&dev); hipDeviceGetAttribute(&cus, hipDeviceAttributeMultiprocessorCount, dev);
    if (hipFuncSetAttribute((const void*)mk_fwd, hipFuncAttributeMaxDynamicSharedMemorySize, LDS_BYTES) != hipSuccess) { fprintf(stderr, "hipFuncSetAttribute failed\n"); g_grid = -1; return; }
    int per_cu = 0; (void)hipOccupancyMaxActiveBlocksPerMultiprocessor(&per_cu, (const void*)mk_fwd, NTHREADS, LDS_BYTES); (void)hipGetLastError();
    g_grid = cus;
}
static void mk_launch(const Params& P, int lo, int hi, hipStream_t stream) {
    hipLaunchKernelGGL(mk_fwd, dim3(g_grid), dim3(NTHREADS), LDS_BYTES, stream, P, lo, hi);
}
}

extern "C" void kernel_launch(void* const* d_in, const int* in_sizes, int n_in, void* d_out, int out_size, void* d_ws, size_t ws_size, hipStream_t stream) {
    mk::mk_setup(); if (mk::g_grid <= 0) return;
    if (ws_size < mk::WS_END) { fprintf(stderr, "workspace too small\n"); return; }
    unsigned char* ws = (unsigned char*)d_ws;
    hipMemsetAsync(ws + mk::WS_CTL, 0, mk::CTL_BYTES, stream);
    mk::Params MP{}; for (int i = 0; i < 26; ++i) MP.in[i] = (const float*)d_in[i]; MP.out = (float*)d_out; MP.ws = ws;
    mk::mk_launch(MP, 0, mk::PH_TOTAL, stream);
}
```

```cpp
#include <hip/hip_runtime.h>
#include <cstdio>
#include <cstdint>
#include <math.h>
#define XB_TMO      128
#define XB_XCNT(j)  (256  + 64 * (j))
#define XB_XSUB(j)  (1280 + 64 * (j))
#define XB_XGEN(j)  (2304 + 64 * (j))
#define XB_TOP      3328
#define XB_TOPGEN   3392
#define XCD_BAR_WORDS 3456
#define XB_SPIN_CAP (1u << 18)
#define LAS __attribute__((address_space(3)))

__device__ __forceinline__ unsigned xb_ld(unsigned* p)              { return __hip_atomic_load(p, __ATOMIC_RELAXED, __HIP_MEMORY_SCOPE_AGENT); }
__device__ __forceinline__ unsigned xb_add(unsigned* p, unsigned v) { return __hip_atomic_fetch_add(p, v, __ATOMIC_RELAXED, __HIP_MEMORY_SCOPE_AGENT); }
__device__ __forceinline__ unsigned xb_xcc_id() { return (unsigned)__builtin_amdgcn_s_getreg((3 << 11) | 20) & 0xFu; }
#define XB_SPIN(cond, bar) do { unsigned _sp = 0; while (cond) { __builtin_amdgcn_s_sleep(1); \
    if ((++_sp & 255u) == 0u) { if (xb_ld(&(bar)[XB_TMO])) break; if (_sp > XB_SPIN_CAP) { atomicAdd(&(bar)[XB_TMO], 1u); break; } } } } while (0)

struct XcdBarrier {
    unsigned* bar; unsigned x;
    volatile LAS unsigned* st;
};

__device__ __forceinline__ XcdBarrier xcd_barrier_post(unsigned* bar, volatile LAS unsigned* st) {
    XcdBarrier b; b.bar = bar; b.x = xb_xcc_id(); b.st = st;
    if (threadIdx.x == 0) (void)xb_add(&bar[XB_XCNT(b.x)], 1u);
    return b;
}
__device__ __forceinline__ void xcd_barrier_complete(unsigned* bar, unsigned x, unsigned& nloc, unsigned& nx) {
    const unsigned G = gridDim.x * gridDim.y * gridDim.z;
    unsigned sum, cnt, mine, sp = 0u;
    for (;;) {
        sum = 0u; cnt = 0u; mine = 0u;
#pragma unroll
        for (unsigned j = 0; j < 16; ++j) { const unsigned c = xb_ld(&bar[XB_XCNT(j)]); sum += c; cnt += (c > 0u) ? 1u : 0u; mine = (j == x) ? c : mine; }
        if (sum == G) break;
        __builtin_amdgcn_s_sleep(1);
        if ((++sp & 255u) == 0u) { if (xb_ld(&bar[XB_TMO])) break; if (sp > XB_SPIN_CAP) { atomicAdd(&bar[XB_TMO], 1u); break; } }
    }
    nloc = mine > 0u ? mine : 1u; nx = cnt > 0u ? cnt : 1u;
}

__device__ __forceinline__ void xcd_barrier(const XcdBarrier& b) {
    asm volatile("s_waitcnt vmcnt(0)" ::: "memory");
    __syncthreads();
    if (threadIdx.x == 0) {
        unsigned* bar = b.bar;
        __builtin_amdgcn_s_waitcnt(0);
        unsigned nloc = b.st[0], nx = b.st[1];
        if (nloc == 0u) { xcd_barrier_complete(bar, b.x, nloc, nx); b.st[0] = nloc; b.st[1] = nx; }
        const unsigned old = xb_add(&bar[XB_XSUB(b.x)], 1u);
        const unsigned gen = old / nloc;
        if (old + 1u == (gen + 1u) * nloc) {
            __builtin_amdgcn_fence(__ATOMIC_RELEASE, "agent");
            asm volatile("s_waitcnt vmcnt(0)" ::: "memory");
            const unsigned og = xb_add(&bar[XB_TOP], 1u);
            const unsigned tg = og / nx;
            if (og + 1u == (tg + 1u) * nx) xb_add(&bar[XB_TOPGEN], 1u);
            else XB_SPIN(xb_ld(&bar[XB_TOPGEN]) == tg, bar);
            __builtin_amdgcn_fence(__ATOMIC_ACQUIRE, "agent");
            xb_add(&bar[XB_XGEN(b.x)], 1u);
            asm volatile("s_waitcnt vmcnt(0)" ::: "memory");
        } else {
            XB_SPIN(xb_ld(&bar[XB_XGEN(b.x)]) == gen, bar);
            __builtin_amdgcn_fence(__ATOMIC_ACQUIRE, "agent");
            asm volatile("s_waitcnt vmcnt(0)" ::: "memory");
        }
    }
    __syncthreads();
}

namespace pg8 {
#define PG8_LAS __attribute__((address_space(3)))
typedef unsigned short bf16_t;
typedef short bf16x8 __attribute__((ext_vector_type(8)));
typedef float f32x4 __attribute__((ext_vector_type(4)));
typedef unsigned u32x4 __attribute__((ext_vector_type(4)));
constexpr int BM = 256, BK = 64, HALF = 128, HTB = HALF * BK * 2  , STAGE_BYTES = 8 * HTB, NXCD = 8, WGM = 8;

__host__ __device__ __forceinline__ int lds_byte(int r, int c) { const int st = (r >> 4) * 2 + (c >> 5), rr = r & 15, cc = c & 31, ob = rr * 64 + cc * 2; return st * 1024 + (ob ^ (((ob >> 9) & 1) << 5)); }
__host__ __device__ __forceinline__ void stage_rc(int b, int& R, int& C) { const int st = b / 1024, sb = b % 1024, swz = sb ^ (((sb >> 9) & 1) << 5); R = (st >> 1) * 16 + swz / 64; C = (st & 1) * 32 + (swz % 64) / 2; }
__host__ __device__ __forceinline__ int perm32(int rho) { const int n = rho >> 4, i = rho & 15; return 8 * (i >> 2) + 4 * n + (i & 3); }

struct Unit { int pm, pn; };
struct Gemm { const bf16_t* A; const bf16_t* Bt; int M, N, K; };

struct StaticOrder {
    int nM, nN, nwg, G, c;
    __host__ __device__ void init(int M, int N, int G_, int c_) { nM = M / BM; nN = N / BM; nwg = nM * nN; G = G_; c = c_; }
    __host__ __device__ bool next(int i, Unit& u) const {
        const long L = (long)i * G + c; if (L >= nwg) return false;
        int wgid = (int)L; { const int q = nwg / NXCD, r = nwg % NXCD, xcd = wgid % NXCD, off = wgid / NXCD; wgid = (xcd < r ? xcd * (q + 1) : r * (q + 1) + (xcd - r) * q) + off; }
        const int nig = WGM * nN, gid = wgid / nig, fm = gid * WGM, gsz = (nM - fm) < WGM ? (nM - fm) : WGM;
        u.pm = fm + ((wgid % nig) % gsz); u.pn = (wgid % nig) / gsz; return true;
    }
    __device__ __forceinline__ void a_ready(const Unit&) const {}
    __device__ __forceinline__ void done(const Unit&) const {}
};
__device__ __forceinline__ unsigned cvt_pk_bf16(float lo, float hi) { unsigned r; asm volatile("v_cvt_pk_bf16_f32 %0, %1, %2" : "=v"(r) : "v"(lo), "v"(hi)); return r; }
typedef float f32x2 __attribute__((ext_vector_type(2)));
template <class Epi, class Sched, bool STAMP = false>
__device__ __forceinline__ void gemm_phase(PG8_LAS unsigned char* lds, const Gemm g, const Sched& S, const Epi& E, unsigned long long* stamps, const int wid  ) {
    int lane_; asm volatile("v_mbcnt_lo_u32_b32 %0, -1, 0\n\tv_mbcnt_hi_u32_b32 %0, -1, %0" : "=v"(lane_));
    const int lane = lane_, tid = wid * 64 + lane, wr = wid >> 2, wc = wid & 3, fr = lane & 15, fq = lane >> 4;
    const int K = g.K, nt = K / BK;
    int ts_lo = 0, ts_hi = 0, nts = 0; const unsigned long long rt_entry = STAMP ? (unsigned long long)wall_clock64() : 0ull;
#define PG8_STAMP() do { if (STAMP && wid == 0 && nts < 64) { const unsigned long long _c = (unsigned long long)clock64(); \
        ts_lo = (lane == nts) ? (int)(unsigned)_c : ts_lo; ts_hi = (lane == nts) ? (int)(unsigned)(_c >> 32) : ts_hi; ++nts; } } while (0)
    PG8_STAMP();
    unsigned voffA[2], voffB[2];
#pragma unroll
    for (int i = 0; i < 2; ++i) { int R, C; stage_rc(tid * 16 + i * 8192, R, C); const int Rb = Epi::PERM ? ((R & ~31) + perm32(R & 31)) : R;
        voffA[i] = (unsigned)(R * K + C) * 2u; voffB[i] = (unsigned)(Rb * K + C) * 2u; }
    const size_t kstep = (size_t)(BK * 2);
    const size_t hstep = (size_t)HALF * K * 2;
    const size_t tstep = 2 * hstep;
    const unsigned ldsw = (unsigned)wid * 1024u;
    const int aoff = lds_byte(wr * 64 + fr, fq * 8), boff = lds_byte(wc * 32 + fr, fq * 8);
#define PG8_SA(b, h) (((b) * 2 + (h)) * HTB)
#define PG8_SB(b, h) ((4 + (b) * 2 + (h)) * HTB)
#define PG8_STAGE(bufoff, gbase, voff) do { _Pragma("unroll") for (int _i = 0; _i < 2; ++_i) \
        __builtin_amdgcn_global_load_lds((const unsigned*)((const char*)(gbase) + (voff)[_i]), (PG8_LAS unsigned*)(lds + (bufoff) + ldsw + _i * 8192), 16, 0, 0); } while (0)
#define PG8_LDA(dst, b, h) do { _Pragma("unroll") for (int m = 0; m < 4; ++m) _Pragma("unroll") for (int k = 0; k < 2; ++k) dst[m][k] = *(const PG8_LAS bf16x8*)(lds + PG8_SA(b, h) + aoff + m * 2048 + k * 1024); } while (0)
#define PG8_LDB(dst, b, h) do { _Pragma("unroll") for (int n = 0; n < 2; ++n) _Pragma("unroll") for (int k = 0; k < 2; ++k) dst[n][k] = *(const PG8_LAS bf16x8*)(lds + PG8_SB(b, h) + boff + n * 2048 + k * 1024); } while (0)
#define PG8_MMA(ai, bj, At, Bt) do { __builtin_amdgcn_s_setprio(1); _Pragma("unroll") for (int m = 0; m < 4; ++m) _Pragma("unroll") for (int n = 0; n < 2; ++n) _Pragma("unroll") for (int k = 0; k < 2; ++k) \
        acc[ai][bj][m][n] = __builtin_amdgcn_mfma_f32_16x16x32_bf16(Bt[n][k], At[m][k], acc[ai][bj][m][n], 0, 0, 0); __builtin_amdgcn_s_setprio(0); } while (0)
#define PG8_WAIT_V(n) asm volatile("s_waitcnt vmcnt(" #n ")" ::: "memory")
#define PG8_WAIT_L(n) asm volatile("s_waitcnt lgkmcnt(" #n ")" ::: "memory")
#define PG8_BAR __builtin_amdgcn_s_barrier()
#define PG8_SCHED __builtin_amdgcn_sched_barrier(0)
    Unit cur, nxt; int ui = 0;
    if (!S.next(0, cur)) return;
    f32x4 acc[2][2][4][2];
#pragma unroll
    for (int a = 0; a < 2; ++a)
#pragma unroll
        for (int b = 0; b < 2; ++b)
#pragma unroll
            for (int m = 0; m < 4; ++m)
#pragma unroll
                for (int n = 0; n < 2; ++n) acc[a][b][m][n] = (f32x4){0.f, 0.f, 0.f, 0.f};
    bf16x8 At[4][2], B0[2][2], B1[2][2];
    const char* cA = (const char*)g.A + (size_t)cur.pm * tstep; const char* cB = (const char*)g.Bt + (size_t)cur.pn * tstep;
    S.a_ready(cur);
    PG8_STAGE(PG8_SB(0, 0), cB, voffB); PG8_STAGE(PG8_SA(0, 0), cA, voffA); PG8_STAGE(PG8_SB(0, 1), cB + hstep, voffB); PG8_STAGE(PG8_SA(0, 1), cA + hstep, voffA);
    if (wr == 1) PG8_BAR;
    PG8_WAIT_V(4); PG8_BAR;
    PG8_STAGE(PG8_SB(1, 0), cB + kstep, voffB); PG8_STAGE(PG8_SA(1, 0), cA + kstep, voffA); PG8_STAGE(PG8_SB(1, 1), cB + hstep + kstep, voffB);
    PG8_WAIT_V(6); PG8_BAR;
    PG8_STAMP();
    for (;;) {
        const bool has_next = S.next(ui + 1, nxt);
        const char* nA = has_next ? (const char*)g.A + (size_t)nxt.pm * tstep : cA; const char* nB = has_next ? (const char*)g.Bt + (size_t)nxt.pn * tstep : cB;
        for (int t = 0; t < nt; t += 2) {
            const bool last = (t == nt - 2);
            const char* a1 = cA + (size_t)(t + 1) * kstep;
            const char* a2 = last ? nA : cA + (size_t)(t + 2) * kstep; const char* b2 = last ? nB : cB + (size_t)(t + 2) * kstep;
            const char* a3 = a2 + kstep; const char* b3 = b2 + kstep;
            if (last && has_next) S.a_ready(nxt);
            PG8_LDB(B0, 0, 0); PG8_SCHED; PG8_LDA(At, 0, 0); PG8_STAGE(PG8_SA(1, 1), a1 + hstep, voffA);
            PG8_WAIT_L(8); PG8_BAR; PG8_WAIT_L(0); PG8_MMA(0, 0, At, B0); PG8_BAR; PG8_SCHED;
            PG8_LDB(B1, 0, 1); PG8_STAGE(PG8_SB(0, 0), b2, voffB);
            PG8_BAR; PG8_WAIT_L(0); PG8_MMA(0, 1, At, B1); PG8_BAR;
            PG8_LDA(At, 0, 1); PG8_STAGE(PG8_SA(0, 0), a2, voffA);
            PG8_BAR; PG8_WAIT_L(0); PG8_MMA(1, 0, At, B0); PG8_BAR; PG8_SCHED;
            PG8_STAGE(PG8_SB(0, 1), b2 + hstep, voffB);
            PG8_WAIT_V(6); PG8_BAR; PG8_MMA(1, 1, At, B1); PG8_BAR;
            PG8_LDB(B0, 1, 0); PG8_SCHED; PG8_LDA(At, 1, 0); PG8_STAGE(PG8_SA(0, 1), a2 + hstep, voffA);
            PG8_WAIT_L(8); PG8_BAR; PG8_WAIT_L(0); PG8_MMA(0, 0, At, B0); PG8_BAR; PG8_SCHED;
            PG8_LDB(B1, 1, 1); PG8_STAGE(PG8_SB(1, 0), b3, voffB);
            PG8_BAR; PG8_WAIT_L(0); PG8_MMA(0, 1, At, B1); PG8_BAR;
            PG8_LDA(At, 1, 1); PG8_STAGE(PG8_SA(1, 0), a3, voffA);
            PG8_BAR; PG8_WAIT_L(0); PG8_MMA(1, 0, At, B0); PG8_BAR; PG8_SCHED;
            PG8_STAGE(PG8_SB(1, 1), b3 + hstep, voffB);
            PG8_WAIT_V(6); PG8_BAR; PG8_MMA(1, 1, At, B1); PG8_BAR;
        }
        PG8_STAMP();
        if constexpr (!Epi::AFTER_DRAIN) { E(acc, cur, wr, wc, fr, fq); S.done(cur); }
        PG8_STAMP();
        if (!has_next) break;
#pragma unroll
        for (int a = 0; a < 2; ++a)
#pragma unroll
            for (int b = 0; b < 2; ++b)
#pragma unroll
                for (int m = 0; m < 4; ++m)
#pragma unroll
                    for (int n = 0; n < 2; ++n) acc[a][b][m][n] = (f32x4){0.f, 0.f, 0.f, 0.f};
        cur = nxt; cA = nA; cB = nB; ++ui;
    }
    PG8_WAIT_V(0);
    if (wr == 0) PG8_BAR;
    PG8_BAR;
    if constexpr (Epi::AFTER_DRAIN) { E.fused(acc, cur, wr, wc, fr, fq, lds, wid, lane); S.done(cur); }
    PG8_STAMP();
    if (STAMP && wid == 0) { stamps[lane] = lane < nts ? (((unsigned long long)(unsigned)ts_hi << 32) | (unsigned)ts_lo) : 0ull;
        if (lane == 62) stamps[62] = rt_entry; if (lane == 63) stamps[63] = (unsigned long long)wall_clock64(); }
#undef PG8_STAMP
#undef PG8_SA
#undef PG8_SB
#undef PG8_STAGE
#undef PG8_LDA
#undef PG8_LDB
#undef PG8_MMA
#undef PG8_WAIT_V
#undef PG8_WAIT_L
#undef PG8_BAR
#undef PG8_SCHED
}
}

namespace mk {
constexpr int D = 1024, NB = 8, S = 2048, L = 256, DEPTH = 4;
constexpr int NLAT = NB * S, NCTX = NB * L, NT = NLAT + NCTX;
constexpr int NIN = 2576;
constexpr int NU = 2560;
constexpr int UQ_A = 0, UK_A = 256, UV_A = 384, UZ = 512, UX = 1024, UB = 1536, UC = 1664, UQ_N = 1792, UK_N = 2048, UV_N = 2304;
constexpr int NEXP = 32, DE = 256;
constexpr int MAXSLOT = 45056;
constexpr int MAXTILE = MAXSLOT / 256;
constexpr int NCH = 18;
constexpr int NWAVES = 8, NTHREADS = 512;

typedef unsigned short bf16_t;
typedef short bf16x8 __attribute__((ext_vector_type(8)));
typedef short s16x4 __attribute__((ext_vector_type(4)));
typedef float f32x4 __attribute__((ext_vector_type(4)));
typedef float f32x2 __attribute__((ext_vector_type(2)));
typedef float f32x16 __attribute__((ext_vector_type(16)));
typedef unsigned u32x4 __attribute__((ext_vector_type(4)));
typedef unsigned u32x2 __attribute__((ext_vector_type(2)));

constexpr size_t MiB = 1u << 20;
constexpr size_t WS_CTL = 0, CTL_BYTES = 1 * MiB;
constexpr size_t WS_MODS = 1 * MiB;
constexpr size_t WS_ROPE = 2 * MiB;
constexpr size_t WS_WDT = 2 * MiB + 65536;
constexpr size_t WS_ROUTE = 3 * MiB;
constexpr size_t WS_DT = 5 * MiB;
constexpr size_t WS_BT_IN = 8 * MiB;
constexpr size_t WS_BT_OUT = 28 * MiB;
constexpr size_t WS_BT_GU = 36 * MiB;
constexpr size_t WS_BT_DN = 164 * MiB;
constexpr size_t WS_XW = 228 * MiB;
constexpr size_t WS_H = 300 * MiB;
constexpr size_t WS_U = 336 * MiB;
constexpr size_t WS_O = 426 * MiB;
constexpr size_t WS_HID = 462 * MiB;
constexpr size_t WS_ST = 484 * MiB;
constexpr size_t WS_PREV = 520 * MiB;
constexpr size_t WS_TOT = 538 * MiB;
constexpr size_t WS_END = 539 * MiB;
constexpr size_t RT_SEL = 0;
constexpr size_t RT_POS = 192 * 1024;
constexpr size_t RT_W = 384 * 1024;
constexpr size_t RT_SLOT = 576 * 1024;
constexpr size_t RT_TILE_E = 768 * 1024;
constexpr size_t RT_NTILES = 768 * 1024 + 4096;
constexpr int CW_BAR = 4096, CW_CNT = 16384, CW_POOL = 20480  , CW_TOF = 32768  ;

constexpr int LDS_SCRATCH = 147456;
constexpr int LDS_CTL_OFF = LDS_SCRATCH;
constexpr int LDS_BYTES = LDS_SCRATCH + 1024;

struct Params { const float* in[26]; float* out; unsigned char* ws; };
enum { I_X = 0, I_C, I_CTX, I_CCTX, I_WMOD, I_BMOD, I_GMIX, I_WIN, I_SINK, I_CONVW, I_CONVB, I_DTB, I_ALOG, I_SSDD, I_SSDG, I_RPB, I_WOUT, I_GFFN,
       I_WRG, I_BRG, I_WRE, I_BRE, I_WEG, I_WEU, I_WED, I_GFIN };

__device__ __forceinline__ unsigned f2bf(float f) { unsigned u = __builtin_bit_cast(unsigned, f); return (u + 0x7fffu + ((u >> 16) & 1u)) >> 16; }
__device__ __forceinline__ unsigned pk2(float lo, float hi) { return f2bf(lo) | (f2bf(hi) << 16); }
__device__ __forceinline__ float bf2f(unsigned short b) { return __builtin_bit_cast(float, ((unsigned)b) << 16); }
__device__ __forceinline__ float bflo(unsigned w) { return __builtin_bit_cast(float, w << 16); }
__device__ __forceinline__ float bfhi(unsigned w) { return __builtin_bit_cast(float, w & 0xffff0000u); }
__device__ __forceinline__ float wave_sum(float v) {
#pragma unroll
    for (int o = 1; o < 64; o <<= 1) v += __shfl_xor(v, o);
    return v;
}
__device__ __forceinline__ unsigned cvtpk(float lo, float hi) { typedef __bf16 bf16x2_t __attribute__((ext_vector_type(2))); f32x2 v = {lo, hi}; bf16x2_t b = __builtin_convertvector(v, bf16x2_t); return __builtin_bit_cast(unsigned, b); }
__device__ __forceinline__ float reduce16_transposed(float (&a)[16], int lane) {
    const bool b5 = lane & 32, b4 = lane & 16, b3 = lane & 8, b2 = lane & 4;
    float v8[8];
#pragma unroll
    for (int i = 0; i < 8; ++i) { const float keep = b5 ? a[i + 8] : a[i], send = b5 ? a[i] : a[i + 8]; v8[i] = keep + __shfl_xor(send, 32); }
    float v4[4];
#pragma unroll
    for (int i = 0; i < 4; ++i) { const float keep = b4 ? v8[i + 4] : v8[i], send = b4 ? v8[i] : v8[i + 4]; v4[i] = keep + __shfl_xor(send, 16); }
    float v2[2];
#pragma unroll
    for (int i = 0; i < 2; ++i) { const float keep = b3 ? v4[i + 2] : v4[i], send = b3 ? v4[i] : v4[i + 2]; v2[i] = keep + __shfl_xor(send, 8); }
    float v1; { const float keep = b2 ? v2[1] : v2[0], send = b2 ? v2[0] : v2[1]; v1 = keep + __shfl_xor(send, 4); }
    v1 += __shfl_xor(v1, 2); v1 += __shfl_xor(v1, 1);
    return v1;
}
__device__ __forceinline__ float silu_f(float x) { return x * __builtin_amdgcn_rcpf(1.0f + __expf(-x)); }
__device__ __forceinline__ float softplus_f(float t) { const float x = __expf(t); const float s = x < 0.01f ? x * (1.0f - x * (0.5f - x * (1.0f / 3.0f))) : __logf(1.0f + x); return t > 20.f ? t : s; }
__device__ __forceinline__ int lane_now() { int l; asm volatile("v_mbcnt_lo_u32_b32 %0, -1, 0\n\tv_mbcnt_hi_u32_b32 %0, -1, %0" : "=v"(l)); return l; }
#ifdef MK_SUB
#define MK_TS(c, k, end) do { if ((k) == MK_SUB && (c).bid == 0) { asm volatile("s_waitcnt vmcnt(0) lgkmcnt(0)" ::: "memory"); if ((c).wave == 0 && lane_now() == 0) { volatile LAS unsigned long long* tw = (volatile LAS unsigned long long*)((c).lds + LDS_CTL_OFF + 512); \
    const unsigned long long now_ = __builtin_amdgcn_s_memrealtime(); if (end) tw[1] += now_ - tw[0]; else tw[0] = now_; } } } while (0)
#else
#define MK_TS(c, k, end) do {} while (0)
#endif
#define LDS_WAIT() asm volatile("s_waitcnt lgkmcnt(0)" ::: "memory")
#define VM_WAIT() asm volatile("s_waitcnt vmcnt(0)" ::: "memory")
}
namespace mk {
struct Ctx {
    LAS unsigned char* lds; int wave, G, bid;
    const Params* P; unsigned char* ws;
};

__device__ __forceinline__ Ctx fresh(const Ctx& c) {
    Ctx n = c; asm volatile("" : "+s"(n.wave), "+s"(n.G), "+s"(n.bid));
    { __attribute__((address_space(1))) unsigned char* g = (__attribute__((address_space(1))) unsigned char*)n.ws; asm volatile("" : "+s"(g)); n.ws = (unsigned char*)g; }
    return n; }
__device__ __forceinline__ void tr_item(const float* W, size_t ldw, bf16_t* dst, size_t ldd, int k0, LAS float* scr, int lane) {
#pragma unroll 8
    for (int i = 0; i < 32; ++i) { const int kk = 2 * i + (lane >> 5); scr[kk * 33 + (lane & 31)] = __builtin_nontemporal_load(W + (size_t)(k0 + kk) * ldw + (lane & 31)); }
    LDS_WAIT(); asm volatile("" ::: "memory");
    const int c = lane & 7;
#pragma unroll
    for (int j = 0; j < 4; ++j) { const int n = (lane >> 3) + 8 * j; const LAS float* s = scr + (8 * c) * 33 + n;
        u32x4 o; o.x = cvtpk(s[0 * 33], s[1 * 33]); o.y = cvtpk(s[2 * 33], s[3 * 33]); o.z = cvtpk(s[4 * 33], s[5 * 33]); o.w = cvtpk(s[6 * 33], s[7 * 33]);
        __builtin_nontemporal_store(o, (u32x4*)(dst + (size_t)n * ldd + k0 + 8 * c)); }
    LDS_WAIT(); asm volatile("" ::: "memory");
}

__device__ __forceinline__ void convert_layer(const Ctx& c, int l, int scr_off) {
    const Params& P = *c.P; const int lane = lane_now();
    LAS float* scr = (LAS float*)(c.lds + scr_off + c.wave * 8448);
    const int gw = c.bid * NWAVES + c.wave, NGW = c.G * NWAVES;
    constexpr int IT_IN = 16 * 80, IT_OUT = 16 * 32, IT_G = 32 * 16 * 8, IT_D = 32 * 4 * 32, IT_L = IT_IN + IT_OUT + 2 * IT_G + IT_D;
    bf16_t* bt_in = (bf16_t*)(c.ws + WS_BT_IN); bf16_t* bt_out = (bf16_t*)(c.ws + WS_BT_OUT); bf16_t* bt_gu = (bf16_t*)(c.ws + WS_BT_GU); bf16_t* bt_dn = (bf16_t*)(c.ws + WS_BT_DN);
    for (int it = gw; it < IT_L; it += NGW) {
        int r = it;
        if (r < IT_IN) { const int kb = r / 80, nb = r % 80; const int n0 = nb * 32, ns = n0 < 1792 ? n0 : n0 + 16;
            tr_item(P.in[I_WIN] + (size_t)l * 1024 * NIN + ns, NIN, bt_in + ((size_t)l * NU + n0) * 1024, 1024, kb * 64, scr, lane); continue; }
        r -= IT_IN;
        if (r < IT_OUT) { const int kb = r / 32, nb = r % 32;
            tr_item(P.in[I_WOUT] + (size_t)l * 1024 * 1024 + nb * 32, 1024, bt_out + ((size_t)l * 1024 + nb * 32) * 1024, 1024, kb * 64, scr, lane); continue; }
        r -= IT_OUT;
        if (r < 2 * IT_G) { const int up = r >= IT_G; if (up) r -= IT_G; const int e = r / 128, q = r % 128, kb = q / 8, nb = q % 8; const int f0 = nb * 32;
            const float* src = P.in[up ? I_WEU : I_WEG] + ((size_t)(l * 32 + e) * 1024) * 256 + f0;
            bf16_t* dst = bt_gu + (((size_t)(l * 32 + e) * 2 + (f0 >> 7)) * 256 + (up ? 128 : 0) + (f0 & 127)) * 1024;
            tr_item(src, 256, dst, 1024, kb * 64, scr, lane); continue; }
        r -= 2 * IT_G;
        { const int e = r / 128, q = r % 128, kb = q / 32, nb = q % 32;
            tr_item(P.in[I_WED] + ((size_t)(l * 32 + e) * 256) * 1024 + nb * 32, 1024, bt_dn + ((size_t)(l * 32 + e) * 1024 + nb * 32) * 256, 256, kb * 64, scr, lane); }
    }
}

__device__ __forceinline__ void phase_p0a(const Ctx& c) {
    const Params& P = *c.P; const int c_lane = lane_now(), c_tid = c.wave * 64 + c_lane;
    LAS float* sc = (LAS float*)c.lds;
    LAS float* red = (LAS float*)(c.lds + 36864);
    for (int i = c_tid; i < 9 * 1024; i += NTHREADS) { const int bb = i >> 10, k = i & 1023; const float v = bb < 8 ? P.in[I_C][bb * 1024 + k] : P.in[I_CCTX][k]; sc[i] = silu_f(v); }
    __syncthreads();
    float* mods = (float*)(c.ws + WS_MODS);
    for (int bi = c.bid; bi < DEPTH * 96; bi += c.G) {
        const int l = bi / 96, n = (bi % 96) * 64 + c_lane;
        const float* w = P.in[I_WMOD] + (size_t)l * 1024 * 6144 + n;
        float acc[9];
#pragma unroll
        for (int bb = 0; bb < 9; ++bb) acc[bb] = 0.f;
        const int kb = c.wave * 128;
#pragma unroll 8
        for (int k = 0; k < 128; ++k) { const float wv = __builtin_nontemporal_load(w + (size_t)(kb + k) * 6144);
#pragma unroll
            for (int bb = 0; bb < 9; ++bb) acc[bb] += sc[bb * 1024 + kb + k] * wv; }
#pragma unroll
        for (int bb = 0; bb < 9; ++bb) red[(c.wave * 9 + bb) * 64 + c_lane] = acc[bb];
        __syncthreads();
        for (int i = c_tid; i < 9 * 64; i += NTHREADS) { const int bb = i >> 6, ln = i & 63; float s = 0.f;
#pragma unroll
            for (int w8 = 0; w8 < 8; ++w8) s += red[(w8 * 9 + bb) * 64 + ln];
            const int nn = (bi % 96) * 64 + ln;
            mods[((size_t)l * 9 + bb) * 6144 + nn] = s + P.in[I_BMOD][l * 6144 + nn]; }
        __syncthreads();
    }
    const int gt = c.bid * NTHREADS + c_tid, NGT = c.G * NTHREADS;
    { f32x2* rope = (f32x2*)(c.ws + WS_ROPE);
      for (int i = gt; i < 64 * 16; i += NGT) { const int pos = i >> 4, fi = i & 15; const float inv = 1.0f / powf(10000.0f, (float)(2 * fi) / 32.0f); const float ang = (float)pos * inv;
          rope[i] = (f32x2){cosf(ang), sinf(ang)}; }
      float* wdt = (float*)(c.ws + WS_WDT);
      for (int i = gt; i < DEPTH * 16 * 1024; i += NGT) { const int k = i & 1023, jd = (i >> 10) & 15, l = i >> 14; wdt[i] = P.in[I_WIN][((size_t)l * 1024 + k) * NIN + 1792 + jd]; } }
    for (int l = 0; l < DEPTH; ++l) convert_layer(c, l, 36864 + 18432);
}

__device__ __forceinline__ void norm_row(const float* xrow, const float* g, const float* shift, const float* scale, bf16_t* hrow, const LAS float* wdt, const float* dtb, float* dtrow, int lane) {
    const f32x4* xr = (const f32x4*)xrow + lane; f32x4 v[4]; float ss = 0.f;
#pragma unroll
    for (int j = 0; j < 4; ++j) { v[j] = xr[64 * j]; ss += (v[j].x * v[j].x + v[j].y * v[j].y) + (v[j].z * v[j].z + v[j].w * v[j].w); }
    const float rstd = __builtin_amdgcn_rsqf(wave_sum(ss) * (1.0f / 1024.0f) + 1e-6f);
#pragma unroll
    for (int j = 0; j < 4; ++j) { const f32x4 gg = ((const f32x4*)g)[lane + 64 * j], sh = ((const f32x4*)shift)[lane + 64 * j], sl = ((const f32x4*)scale)[lane + 64 * j];
        v[j] = (v[j] * rstd) * gg * (sl + 1.0f) + sh;
        u32x2 o; o.x = cvtpk(v[j].x, v[j].y); o.y = cvtpk(v[j].z, v[j].w); ((u32x2*)hrow)[lane + 64 * j] = o; }
    {
        float pa[16];
#pragma unroll
        for (int jd = 0; jd < 16; ++jd) { float a = 0.f;
#pragma unroll
            for (int j = 0; j < 4; ++j) { const f32x4 w = ((const LAS f32x4*)(wdt + jd * 1024))[lane + 64 * j]; a += (v[j].x * w.x + v[j].y * w.y) + (v[j].z * w.z + v[j].w * w.w); }
            pa[jd] = a; if ((jd & 3) == 3) __builtin_amdgcn_sched_barrier(0); }
        const float tot = reduce16_transposed(pa, lane); const int jd_l = ((lane >> 5) & 1) * 8 + ((lane >> 4) & 1) * 4 + ((lane >> 3) & 1) * 2 + ((lane >> 2) & 1);
        if ((lane & 3) == 0) dtrow[jd_l] = softplus_f(tot + dtb[jd_l]);
    }
}
__device__ __forceinline__ void phase_norm1(const Ctx& c, int l, const float* xlat, const float* xctx) {
    const Params& P = *c.P; const float* mods = (const float*)(c.ws + WS_MODS) + (size_t)l * 9 * 6144;
    bf16_t* H = (bf16_t*)(c.ws + WS_H); float* dtv = (float*)(c.ws + WS_DT); const float* wdt_g = (const float*)(c.ws + WS_WDT) + (size_t)l * 16 * 1024;
    const int gw = c.bid * NWAVES + c.wave, NGW = c.G * NWAVES; const int c_lane = lane_now();
    LAS float* wdt = (LAS float*)c.lds;
    for (int i = c.wave * 64 + c_lane; i < 16 * 256; i += NTHREADS) ((LAS f32x4*)wdt)[i] = ((const f32x4*)wdt_g)[i];
    __syncthreads();
    for (int row = gw; row < NT; row += NGW) {
        const int bb = row < NLAT ? row >> 11 : 8; const float* xr = row < NLAT ? xlat + (size_t)row * 1024 : xctx + (size_t)(row - NLAT) * 1024;
        norm_row(xr, P.in[I_GMIX] + l * 1024, mods + bb * 6144, mods + bb * 6144 + 1024, H + (size_t)row * 1024, wdt, P.in[I_DTB] + l * 16, dtv + (size_t)row * 16, c_lane);
    }
}

constexpr float QSCALE_Q = 0.125f * 1.4426950408889634f;
struct EpiInProj {
    static constexpr bool PERM = false, AFTER_DRAIN = false;
    bf16_t* U; const f32x2* rope;
    __device__ __forceinline__ void operator()(const pg8::f32x4 (&acc)[2][2][4][2], const pg8::Unit& u, int wr, int wc, int fr, int fq) const {
        const int row0 = u.pm * 256 + wr * 64 + fr, col0 = u.pn * 256 + wc * 32 + 4 * fq;
#pragma unroll
        for (int bj = 0; bj < 2; ++bj) {
            const int cb = u.pn * 256 + bj * 128 + wc * 32;
            const bool do_rope = (u.pm < 64) && (cb < 384); const bool is_q = (cb < 256) || (cb >= 1792 && cb < 2048);
#pragma unroll
            for (int ai = 0; ai < 2; ++ai)
#pragma unroll
                for (int m = 0; m < 4; ++m) {
                    const int row = row0 + ai * 128 + m * 16;
                    pg8::f32x4 x1 = acc[ai][bj][m][0], x2 = acc[ai][bj][m][1];
                    if (do_rope) { const int t = row & 2047; const int pos = ((cb >> 5) & 1) ? (t & 63) : (t >> 6);
                        const f32x4* rp = (const f32x4*)(rope + pos * 16 + 4 * fq); const f32x4 r0 = rp[0], r1 = rp[1];
                        const pg8::f32x4 cs = {r0.x, r0.z, r1.x, r1.z}, sn = {r0.y, r0.w, r1.y, r1.w};
                        const pg8::f32x4 y1 = x1 * cs - x2 * sn, y2 = x2 * cs + x1 * sn; x1 = y1; x2 = y2; }
                    if (is_q) { x1 = x1 * QSCALE_Q; x2 = x2 * QSCALE_Q; }
                    bf16_t* rowp = U + (size_t)row * NU + col0 + bj * 128;
                    u32x2 o1, o2; o1.x = cvtpk(x1[0], x1[1]); o1.y = cvtpk(x1[2], x1[3]); o2.x = cvtpk(x2[0], x2[1]); o2.y = cvtpk(x2[2], x2[3]);
                    *(u32x2*)rowp = o1; *(u32x2*)(rowp + 16) = o2;
                }
        }
    }
};
struct EpiOutProj {
    static constexpr bool PERM = false, AFTER_DRAIN = false;
    const float* xlat; const float* xctx; float* xw; const float* mods_l;
    __device__ __forceinline__ void operator()(const pg8::f32x4 (&acc)[2][2][4][2], const pg8::Unit& u, int wr, int wc, int fr, int fq) const {
        const int row0 = u.pm * 256 + wr * 64 + fr, col0 = u.pn * 256 + wc * 32 + 4 * fq;
        const int bb = u.pm < 64 ? (u.pm >> 3) : 8; const float* gate = mods_l + bb * 6144 + 2 * 1024;
        const float* src = u.pm < 64 ? xlat : xctx - (size_t)NLAT * 1024;
        f32x4 gv[2][2];
#pragma unroll
        for (int bj = 0; bj < 2; ++bj)
#pragma unroll
            for (int n = 0; n < 2; ++n) gv[bj][n] = *(const f32x4*)(gate + col0 + bj * 128 + n * 16);
#pragma unroll
        for (int ai = 0; ai < 2; ++ai)
#pragma unroll
            for (int m = 0; m < 4; ++m) { const size_t off = (size_t)(row0 + ai * 128 + m * 16) * 1024 + col0;
#pragma unroll
                for (int bj = 0; bj < 2; ++bj)
#pragma unroll
                    for (int n = 0; n < 2; ++n) { const f32x4 xo = *(const f32x4*)(src + off + bj * 128 + n * 16); const pg8::f32x4 a = acc[ai][bj][m][n];
                        f32x4 r; r.x = xo.x + gv[bj][n].x * a[0]; r.y = xo.y + gv[bj][n].y * a[1]; r.z = xo.z + gv[bj][n].z * a[2]; r.w = xo.w + gv[bj][n].w * a[3];
                        *(f32x4*)(xw + off + bj * 128 + n * 16) = r; } }
    }
};
struct EpiGateUp {
    static constexpr bool PERM = false, AFTER_DRAIN = false;
    bf16_t* HID;
    __device__ __forceinline__ void operator()(const pg8::f32x4 (&acc)[2][2][4][2], const pg8::Unit& u, int wr, int wc, int fr, int fq) const {
        const int row0 = u.pm * 256 + wr * 64 + fr, col0 = (u.pn & 1) * 128 + wc * 32 + 4 * fq;
#pragma unroll
        for (int ai = 0; ai < 2; ++ai)
#pragma unroll
            for (int m = 0; m < 4; ++m) { bf16_t* rowp = HID + (size_t)(row0 + ai * 128 + m * 16) * 256 + col0;
#pragma unroll
                for (int n = 0; n < 2; ++n) { const pg8::f32x4 g = acc[ai][0][m][n], up = acc[ai][1][m][n]; float h[4];
#pragma unroll
                    for (int i = 0; i < 4; ++i) h[i] = g[i] * __builtin_amdgcn_rcpf(1.0f + __expf(-g[i])) * up[i];
                    u32x2 o; o.x = cvtpk(h[0], h[1]); o.y = cvtpk(h[2], h[3]); *(u32x2*)(rowp + n * 16) = o; } }
    }
};
struct EpiDown {
    static constexpr bool PERM = false, AFTER_DRAIN = false;
    bf16_t* OUT;
    __device__ __forceinline__ void operator()(const pg8::f32x4 (&acc)[2][2][4][2], const pg8::Unit& u, int wr, int wc, int fr, int fq) const {
        const int row0 = u.pm * 256 + wr * 64 + fr, col0 = (u.pn & 3) * 256 + wc * 32 + 4 * fq;
#pragma unroll
        for (int ai = 0; ai < 2; ++ai)
#pragma unroll
            for (int m = 0; m < 4; ++m) { bf16_t* rowp = OUT + (size_t)(row0 + ai * 128 + m * 16) * 1024 + col0;
#pragma unroll
                for (int bj = 0; bj < 2; ++bj)
#pragma unroll
                    for (int n = 0; n < 2; ++n) { const pg8::f32x4 a = acc[ai][bj][m][n]; u32x2 o; o.x = cvtpk(a[0], a[1]); o.y = cvtpk(a[2], a[3]); *(u32x2*)(rowp + bj * 128 + n * 16) = o; } }
    }
};
template <int NSUB> struct ExpertOrder {
    const int* tile_e; int ntiles, G, c;
    __device__ __forceinline__ bool next(int i, pg8::Unit& u) const {
        const long Lx = (long)i * G + c; if (Lx >= (long)ntiles * NSUB) return false;
        const int tile = (int)(Lx / NSUB), sub = (int)(Lx % NSUB); u.pm = tile; u.pn = __builtin_amdgcn_readfirstlane(tile_e[tile]) * NSUB + sub; return true; }
    __device__ __forceinline__ void a_ready(const pg8::Unit&) const {}
    __device__ __forceinline__ void done(const pg8::Unit&) const {}
};
}
namespace mk {
__device__ __forceinline__ int crow(int r, int hi) { return (r & 3) + 8 * (r >> 2) + 4 * hi; }
typedef short v4i16_t __attribute__((ext_vector_type(4)));
__device__ __forceinline__ s16x4 lds_tr(const LAS unsigned char* p) { return __builtin_bit_cast(s16x4, __builtin_amdgcn_ds_read_tr16_b64_v4i16((LAS v4i16_t*)p)); }

__device__ __forceinline__ f32x16 zero16() { f32x16 z;
#pragma unroll
    for (int r = 0; r < 16; ++r) z[r] = 0.f;
    asm volatile("" : "+v"(z)); return z; }
constexpr int AT_K = 0, AT_V = 16384, AT_BIAS = 32768, AT_BYTES = 32768 + 2048;
constexpr float LOG2E = 1.4426950408889634f, QSCALE = 0.125f * 1.4426950408889634f;

template <int TYPE> __device__ __forceinline__ void attn_unit(const Ctx& c, int l, int ua, int ub, int uc) {
    const Params& P = *c.P; const bf16_t* U = (const bf16_t*)(c.ws + WS_U); bf16_t* O = (bf16_t*)(c.ws + WS_O);
    const int tid_l = c.wave * 64 + lane_now();
    const int lane = tid_l & 63, w = c.wave, r32 = lane & 31, hi = lane >> 5;
    LAS unsigned char* lds = c.lds;
    int b = ua, qrow, qcol, ocol, kcol, vcol, ntl, ntiles; float sinkv = 0.f; bool has_sink = false;
    int qpos = 0, kpos_base = 0;
    int qr = 0, qc = 0, rmin = 0, rs_w = 0, cs_q = 0, rs_q = 0, ks = 0;
    if (TYPE == 0) { const int n = ub, g = uc; const int qh = 2 * g + (w >> 2); qpos = n * 128 + (w & 3) * 32 + r32; qrow = b * S + qpos; qcol = UQ_A + qh * 64; ocol = qh * 64; kcol = UK_A + g * 64; vcol = UV_A + g * 64;
        kpos_base = n * 128 - 128; ntl = 6; has_sink = true; sinkv = P.in[I_SINK][l * 4 + qh]; }
    else if (TYPE == 1) { const int rg = ub, h = uc; qr = 4 * rg + 2 * (w >> 2) + (r32 >> 4); qc = 16 * (w & 3) + (r32 & 15); qrow = b * S + qr * 64 + qc; qcol = UQ_N + h * 64; ocol = 768 + h * 64; kcol = UK_N + h * 64; vcol = UV_N + h * 64;
        int r0 = 4 * rg - 4; if (r0 < 0) r0 = 0; if (r0 > 24) r0 = 24; rmin = r0; int r1 = 4 * rg + 3 - 4; if (r1 < 0) r1 = 0; if (r1 > 24) r1 = 24; ntl = r1 + 8 - rmin;
        rs_q = qr - 4; if (rs_q < 0) rs_q = 0; if (rs_q > 24) rs_q = 24; cs_q = qc - 8; if (cs_q < 0) cs_q = 0; if (cs_q > 48) cs_q = 48;
        { const int r0w = 4 * rg + 2 * (w >> 2); rs_w = r0w - 4; if (rs_w < 0) rs_w = 0; if (rs_w > 24) rs_w = 24; const int cb = w & 3; ks = cb == 0 ? 0 : (cb == 1 ? 8 : (cb == 2 ? 24 : 32)); } }
    else { const int hh = ub; qrow = NLAT + b * L + w * 32 + r32; ntl = 0;
        if (hh < 4) { qcol = UQ_A + hh * 64; ocol = hh * 64; kcol = UK_A + (hh >> 1) * 64; vcol = UV_A + (hh >> 1) * 64; has_sink = true; sinkv = P.in[I_SINK][l * 4 + hh]; }
        else { const int h = hh - 4; qcol = UQ_N + h * 64; ocol = 768 + h * 64; kcol = UK_N + h * 64; vcol = UV_N + h * 64; } }
    ntiles = ntl + 4;
    if (TYPE == 1) { LAS float* bt = (LAS float*)(lds + AT_BIAS); const float* src = P.in[I_RPB] + (size_t)(l * 4 + uc) * 465; for (int i = tid_l; i < 465; i += NTHREADS) bt[i] = src[i] * LOG2E; }
    bf16x8 qf[4];
#pragma unroll
    for (int d0 = 0; d0 < 4; ++d0) qf[d0] = *(const bf16x8*)(U + (size_t)qrow * NU + qcol + d0 * 16 + hi * 8);
    f32x16 o0 = zero16(), o1 = zero16(); float m = -1e30f, lsum = 0.f;
    auto tile_row = [&](int t) -> int {
        if (t >= ntl) return NLAT + b * L + (t - ntl) * 64;
        if (TYPE == 0) { const int kp = kpos_base + 64 * t; return (kp < 0 || kp >= S) ? -1 : b * S + kp; }
        if (TYPE == 1) return b * S + (rmin + t) * 64;
        return -1; };
    auto stage = [&](int t, int slot) {
        const int kr0 = tile_row(t); if (kr0 < 0) return;
        const bf16_t* ks = U + (size_t)(kr0 + lane) * NU + kcol + 8 * w;
        const bf16_t* vs = U + (size_t)(kr0 + 16 * (w & 3) + (lane >> 2)) * NU + vcol + (w >> 2) * 32 + (lane & 3) * 8;
        __builtin_amdgcn_global_load_lds((const unsigned*)ks, (LAS unsigned*)(lds + AT_K + slot * 8192 + w * 1024), 16, 0, 0);
        __builtin_amdgcn_global_load_lds((const unsigned*)vs, (LAS unsigned*)(lds + AT_V + slot * 8192 + w * 1024), 16, 0, 0); };
    stage(0, 0);
    for (int t = 0; t < ntiles; ++t) {
        VM_WAIT(); __syncthreads();
        if (t + 1 < ntiles) stage(t + 1, (t + 1) & 1);
        const int kr0 = tile_row(t);
        bool active = kr0 >= 0; int maskmode = 0;
        if (t < ntl) {
            if (TYPE == 0) { const int q0 = qpos - r32, k0 = kpos_base + 64 * t;
                const int dmin = (k0 > q0 + 31) ? k0 - (q0 + 31) : ((q0 > k0 + 63) ? q0 - (k0 + 63) : 0);
                const int dmax = (q0 + 31 - k0) > (k0 + 63 - q0) ? (q0 + 31 - k0) : (k0 + 63 - q0);
                if (dmin > 128) active = false; maskmode = dmax > 128 ? 1 : 0; }
            if (TYPE == 1) { const int kr = rmin + t; if (kr < rs_w || kr > rs_w + 8) active = false; maskmode = 1; }
        }
        if (TYPE == 1 && active && t < ntl) {
            const int kr = rmin + t;
            const LAS unsigned char* Ks = lds + AT_K + (t & 1) * 8192 + hi * 1024 + (ks + r32) * 16;
            f32x16 p0 = zero16();
#pragma unroll
            for (int d0 = 0; d0 < 4; ++d0) p0 = __builtin_amdgcn_mfma_f32_32x32x16_bf16(*(const LAS bf16x8*)(Ks + d0 * 2048), qf[d0], p0, 0, 0, 0);
            const bool rowok = (unsigned)(kr - rs_q) < 8u;
            const LAS float* bt = (const LAS float*)(lds + AT_BIAS) + (kr - qr + 7) * 31 - qc + 15 + ks;
            float rm = -1e30f;
#pragma unroll
            for (int r = 0; r < 16; ++r) { const int kc = ks + crow(r, hi); const bool v0 = rowok && (unsigned)(kc - cs_q) < 16u; const float b0 = v0 ? bt[crow(r, hi)] : 0.f;
                p0[r] = v0 ? p0[r] + b0 : -1e30f; rm = fmaxf(rm, p0[r]); }
            rm = fmaxf(rm, __shfl_xor(rm, 32));
            const float mn = fmaxf(m, rm); const float alpha = __builtin_amdgcn_exp2f(m - mn); m = mn;
            float ps = 0.f;
#pragma unroll
            for (int r = 0; r < 16; ++r) { p0[r] = p0[r] > -1e29f ? __builtin_amdgcn_exp2f(p0[r] - mn) : 0.f; ps += p0[r]; }
            lsum = lsum * alpha + ps;
#pragma unroll
            for (int r = 0; r < 16; ++r) { o0[r] *= alpha; o1[r] *= alpha; }
            u32x4 t0 = {cvtpk(p0[0], p0[1]), cvtpk(p0[2], p0[3]), cvtpk(p0[4], p0[5]), cvtpk(p0[6], p0[7])}, t1 = {cvtpk(p0[8], p0[9]), cvtpk(p0[10], p0[11]), cvtpk(p0[12], p0[13]), cvtpk(p0[14], p0[15])};
            const bf16x8 pa0 = __builtin_bit_cast(bf16x8, t0), pa1 = __builtin_bit_cast(bf16x8, t1);
            const LAS unsigned char* Vs = lds + AT_V + (t & 1) * 8192 + (ks + 4 * hi + ((lane & 15) >> 2)) * 64 + ((lane >> 4) & 1) * 32 + (lane & 3) * 8;
#pragma unroll
            for (int s2 = 0; s2 < 2; ++s2) {
                const s16x4 a0 = lds_tr(Vs + s2 * 1024), a1 = lds_tr(Vs + s2 * 1024 + 512), b0 = lds_tr(Vs + 4096 + s2 * 1024), b1 = lds_tr(Vs + 4096 + s2 * 1024 + 512);
                const bf16x8 v0 = {a0[0], a0[1], a0[2], a0[3], a1[0], a1[1], a1[2], a1[3]}, v1 = {b0[0], b0[1], b0[2], b0[3], b1[0], b1[1], b1[2], b1[3]};
                o0 = __builtin_amdgcn_mfma_f32_32x32x16_bf16(v0, s2 == 0 ? pa0 : pa1, o0, 0, 0, 0); o1 = __builtin_amdgcn_mfma_f32_32x32x16_bf16(v1, s2 == 0 ? pa0 : pa1, o1, 0, 0, 0); }
        } else
        if (active) {
            const LAS unsigned char* Ks = lds + AT_K + (t & 1) * 8192 + hi * 1024 + r32 * 16;
            f32x16 p0 = zero16(), p1 = zero16();
#pragma unroll
            for (int d0 = 0; d0 < 4; ++d0) { const bf16x8 k0f = *(const LAS bf16x8*)(Ks + d0 * 2048), k1f = *(const LAS bf16x8*)(Ks + d0 * 2048 + 512);
                p0 = __builtin_amdgcn_mfma_f32_32x32x16_bf16(k0f, qf[d0], p0, 0, 0, 0); p1 = __builtin_amdgcn_mfma_f32_32x32x16_bf16(k1f, qf[d0], p1, 0, 0, 0); }
            if (maskmode == 0) {
#pragma unroll
                for (int r = 0; r < 16; ++r) { }
            } else if (TYPE == 0) { const int kb = kpos_base + 64 * t;
#pragma unroll
                for (int r = 0; r < 16; ++r) { const int k0 = kb + crow(r, hi), k1 = k0 + 32; int d0 = qpos - k0; d0 = d0 < 0 ? -d0 : d0; int d1 = qpos - k1; d1 = d1 < 0 ? -d1 : d1;
                    p0[r] = d0 <= 128 ? p0[r] : -1e30f; p1[r] = d1 <= 128 ? p1[r] : -1e30f; }
            } else if (TYPE == 1) { const LAS float* bt = (const LAS float*)(lds + AT_BIAS) + (rmin + t - qr + 7) * 31 - qc + 15;
#pragma unroll
                for (int r = 0; r < 16; ++r) { const int k0 = crow(r, hi), k1 = k0 + 32; const bool v0 = (unsigned)(k0 - cs_q) < 16u, v1 = (unsigned)(k1 - cs_q) < 16u;
                    const float b0 = v0 ? bt[k0] : 0.f, b1 = v1 ? bt[k1] : 0.f;
                    p0[r] = v0 ? p0[r] + b0 : -1e30f; p1[r] = v1 ? p1[r] + b1 : -1e30f; }
            }
            float rm = fmaxf(p0[0], p1[0]);
#pragma unroll
            for (int r = 1; r < 16; ++r) rm = fmaxf(rm, fmaxf(p0[r], p1[r]));
            rm = fmaxf(rm, __shfl_xor(rm, 32));
            const float mn = fmaxf(m, rm); const float alpha = __builtin_amdgcn_exp2f(m - mn); m = mn;
            float ps = 0.f;
            if (maskmode == 0) {
#pragma unroll
                for (int r = 0; r < 16; ++r) { p0[r] = __builtin_amdgcn_exp2f(p0[r] - mn); p1[r] = __builtin_amdgcn_exp2f(p1[r] - mn); ps += p0[r] + p1[r]; }
            } else {
#pragma unroll
                for (int r = 0; r < 16; ++r) { p0[r] = p0[r] > -1e29f ? __builtin_amdgcn_exp2f(p0[r] - mn) : 0.f; p1[r] = p1[r] > -1e29f ? __builtin_amdgcn_exp2f(p1[r] - mn) : 0.f; ps += p0[r] + p1[r]; }
            }
            lsum = lsum * alpha + ps;
#pragma unroll
            for (int r = 0; r < 16; ++r) { o0[r] *= alpha; o1[r] *= alpha; }
            bf16x8 pa[4];
            { u32x4 t0 = {cvtpk(p0[0], p0[1]), cvtpk(p0[2], p0[3]), cvtpk(p0[4], p0[5]), cvtpk(p0[6], p0[7])}; pa[0] = __builtin_bit_cast(bf16x8, t0);
              u32x4 t1 = {cvtpk(p0[8], p0[9]), cvtpk(p0[10], p0[11]), cvtpk(p0[12], p0[13]), cvtpk(p0[14], p0[15])}; pa[1] = __builtin_bit_cast(bf16x8, t1);
              u32x4 t2 = {cvtpk(p1[0], p1[1]), cvtpk(p1[2], p1[3]), cvtpk(p1[4], p1[5]), cvtpk(p1[6], p1[7])}; pa[2] = __builtin_bit_cast(bf16x8, t2);
              u32x4 t3 = {cvtpk(p1[8], p1[9]), cvtpk(p1[10], p1[11]), cvtpk(p1[12], p1[13]), cvtpk(p1[14], p1[15])}; pa[3] = __builtin_bit_cast(bf16x8, t3); }
            const LAS unsigned char* Vs = lds + AT_V + (t & 1) * 8192 + (4 * hi + ((lane & 15) >> 2)) * 64 + ((lane >> 4) & 1) * 32 + (lane & 3) * 8;
#pragma unroll
            for (int ks = 0; ks < 4; ++ks) {
                const s16x4 a0 = lds_tr(Vs + ks * 1024), a1 = lds_tr(Vs + ks * 1024 + 512), b0 = lds_tr(Vs + 4096 + ks * 1024), b1 = lds_tr(Vs + 4096 + ks * 1024 + 512);
                const bf16x8 v0 = {a0[0], a0[1], a0[2], a0[3], a1[0], a1[1], a1[2], a1[3]}, v1 = {b0[0], b0[1], b0[2], b0[3], b1[0], b1[1], b1[2], b1[3]};
                o0 = __builtin_amdgcn_mfma_f32_32x32x16_bf16(v0, pa[ks], o0, 0, 0, 0); o1 = __builtin_amdgcn_mfma_f32_32x32x16_bf16(v1, pa[ks], o1, 0, 0, 0); }
        }
    }
    lsum += __shfl_xor(lsum, 32);
    if (has_sink) { const float s2 = sinkv * LOG2E; const float mn = fmaxf(m, s2); const float alpha = __builtin_amdgcn_exp2f(m - mn); lsum = lsum * alpha + __builtin_amdgcn_exp2f(s2 - mn);
#pragma unroll
        for (int r = 0; r < 16; ++r) { o0[r] *= alpha; o1[r] *= alpha; } }
    const float il = 1.0f / lsum;
    bf16_t* orow = O + (size_t)qrow * 1024 + ocol + 4 * hi;
#pragma unroll
    for (int g4 = 0; g4 < 4; ++g4) { u32x2 a, bq; a.x = cvtpk(o0[4 * g4] * il, o0[4 * g4 + 1] * il); a.y = cvtpk(o0[4 * g4 + 2] * il, o0[4 * g4 + 3] * il);
        bq.x = cvtpk(o1[4 * g4] * il, o1[4 * g4 + 1] * il); bq.y = cvtpk(o1[4 * g4 + 2] * il, o1[4 * g4 + 3] * il);
        *(u32x2*)(orow + 8 * g4) = a; *(u32x2*)(orow + 32 + 8 * g4) = bq; }
    VM_WAIT(); __syncthreads();
}

__device__ __forceinline__ void ctx_outproj_tile(const Ctx& c, int l, int tile) {
    const int lane = lane_now(), r32 = lane & 31, hi = lane >> 5, w = c.wave;
    const int r0 = 64 * (tile >> 3) + 32 * (w >> 2), c0 = 128 * (tile & 7) + 32 * (w & 3);
    const bf16_t* A = (const bf16_t*)(c.ws + WS_O) + (size_t)(NLAT + r0 + r32) * 1024 + 8 * hi;
    const bf16_t* B = (const bf16_t*)(c.ws + WS_BT_OUT) + ((size_t)l * 1024 + c0 + r32) * 1024 + 8 * hi;
    f32x16 acc = zero16();
#pragma unroll 8
    for (int s = 0; s < 64; ++s) { const bf16x8 af = *(const bf16x8*)(A + 16 * s), bf = *(const bf16x8*)(B + 16 * s); acc = __builtin_amdgcn_mfma_f32_32x32x16_bf16(af, bf, acc, 0, 0, 0); }
    float* xw = (float*)(c.ws + WS_XW) + (size_t)NLAT * 1024; const float* xs = l == 0 ? c.P->in[I_CTX] : xw;
    const float gate = ((const float*)(c.ws + WS_MODS))[((size_t)l * 9 + 8) * 6144 + 2 * 1024 + c0 + r32];
#pragma unroll
    for (int r = 0; r < 16; ++r) { const size_t off = (size_t)(r0 + crow(r, hi)) * 1024 + c0 + r32; xw[off] = xs[off] + gate * acc[r]; }
}
}
namespace mk {
__device__ __forceinline__ int chunk_row(int b, int cidx, int& t0, int& len) { if (cidx < 2) { t0 = 128 * cidx; len = L; return NLAT + b * L + t0; } t0 = 128 * (cidx - 2); len = S; return b * S + t0; }

constexpr int SD_X = 0;
constexpr int SD_B = 65536;
constexpr int SD_C = 81920;
constexpr int SD_WT = 98304;
constexpr int SD_WV = 106496;
constexpr int SD_MISC = 110592;
constexpr int SD_SSQ = 110720;
constexpr int SD_BYTES = 114816;

template <bool WITH_C, bool B_TR> __device__ __forceinline__ void ssd_conv_stage(const Ctx& c, int l, int g, int rowbase, int t0, int len) {
    const Params& P = *c.P; const bf16_t* U = (const bf16_t*)(c.ws + WS_U);
    const float* cw = P.in[I_CONVW] + (size_t)l * 5 * 768; const float* cb = P.in[I_CONVB] + (size_t)l * 768;
    constexpr int NCG = WITH_C ? 48 : 40;
    const int tid_l = c.wave * 64 + lane_now();
    for (int it = tid_l; it < NCG * 16; it += NTHREADS) {
        const int cg = it % NCG, seg = it / NCG; const int tb = seg * 8;
        int ucol, ch, kind;
        if (cg < 32) { kind = 0; ch = (4 * g) * 64 + cg * 8; ucol = UX + ch; } else if (cg < 40) { kind = 1; ch = 512 + g * 64 + (cg - 32) * 8; ucol = UB + g * 64 + (cg - 32) * 8; } else { kind = 2; ch = 640 + g * 64 + (cg - 40) * 8; ucol = UC + g * 64 + (cg - 40) * 8; }
        float wt[5][8], bias[8];
#pragma unroll
        for (int j = 0; j < 5; ++j) { const f32x4 a = *(const f32x4*)(cw + j * 768 + ch), bq = *(const f32x4*)(cw + j * 768 + ch + 4); wt[j][0] = a.x; wt[j][1] = a.y; wt[j][2] = a.z; wt[j][3] = a.w; wt[j][4] = bq.x; wt[j][5] = bq.y; wt[j][6] = bq.z; wt[j][7] = bq.w; }
        { const f32x4 a = *(const f32x4*)(cb + ch), bq = *(const f32x4*)(cb + ch + 4); bias[0] = a.x; bias[1] = a.y; bias[2] = a.z; bias[3] = a.w; bias[4] = bq.x; bias[5] = bq.y; bias[6] = bq.z; bias[7] = bq.w; }
        u32x4 raw[12];
#pragma unroll
        for (int i = 0; i < 12; ++i) { const int tt = t0 + tb + i - 2; raw[i] = (tt >= 0 && tt < len) ? *(const u32x4*)(U + (size_t)(rowbase + tb + i - 2) * NU + ucol) : (u32x4){0u, 0u, 0u, 0u}; }
#pragma unroll
        for (int i = 0; i < 8; ++i) { float acc[8];
#pragma unroll
            for (int e = 0; e < 8; ++e) acc[e] = bias[e];
#pragma unroll
            for (int j = 0; j < 5; ++j) { const u32x4 rw = raw[i + j];
                acc[0] += bflo(rw.x) * wt[j][0]; acc[1] += bfhi(rw.x) * wt[j][1]; acc[2] += bflo(rw.y) * wt[j][2]; acc[3] += bfhi(rw.y) * wt[j][3];
                acc[4] += bflo(rw.z) * wt[j][4]; acc[5] += bfhi(rw.z) * wt[j][5]; acc[6] += bflo(rw.w) * wt[j][6]; acc[7] += bfhi(rw.w) * wt[j][7]; }
#pragma unroll
            for (int e = 0; e < 8; ++e) acc[e] = silu_f(acc[e]);
            u32x4 o; o.x = cvtpk(acc[0], acc[1]); o.y = cvtpk(acc[2], acc[3]); o.z = cvtpk(acc[4], acc[5]); o.w = cvtpk(acc[6], acc[7]);
            const int t = tb + i; int off;
            if (kind == 0) { const int hl = cg >> 3, p0 = (cg & 7) * 8; off = SD_X + hl * 16384 + (p0 >> 5) * 8192 + t * 64 + (p0 & 31) * 2; }
            else { const int n0 = ((kind == 1) ? (cg - 32) : (cg - 40)) * 8; const int base = (kind == 1) ? SD_B : SD_C;
                if (kind == 1 && B_TR) off = base + (n0 >> 5) * 8192 + t * 64 + (n0 & 31) * 2; else off = base + (n0 >> 3) * 2048 + t * 16; }
            *(LAS u32x4*)(c.lds + off) = o; }
    }
}
__device__ __forceinline__ void ssd_scan_stage(const Ctx& c, int l, int g, int rowbase) {
    const Params& P = *c.P; const float* dtv = (const float*)(c.ws + WS_DT);
    const int tid_l = c.wave * 64 + lane_now();
    const int hl = c.wave >> 1, dir = c.wave & 1, hh = 4 * g + hl, lane = tid_l & 63;
    const float a = -__expf(P.in[I_ALOG][l * 16 + dir * 8 + hh]);
    const float d0 = dtv[(size_t)(rowbase + 2 * lane) * 16 + dir * 8 + hh], d1 = dtv[(size_t)(rowbase + 2 * lane + 1) * 16 + dir * 8 + hh];
    const float x0 = d0 * a, x1 = d1 * a; float ps = x0 + x1, inc = ps;
    if (dir == 0) {
#pragma unroll
        for (int o = 1; o < 64; o <<= 1) { const float v = __shfl_up(inc, o); if (lane >= o) inc += v; }
    } else {
#pragma unroll
        for (int o = 1; o < 64; o <<= 1) { const float v = __shfl_down(inc, o); if (lane + o < 64) inc += v; }
    }
    const float ex = inc - ps;
    float a0, a1;
    if (dir == 0) { a0 = ex + x0; a1 = ex + ps; } else { a1 = ex + x1; a0 = ex + ps; }
    const float total = dir == 0 ? __shfl(inc, 63) : __shfl(inc, 0);
    LAS float* wt = (LAS float*)(c.lds + SD_WT) + hl * 512;
    wt[dir * 128 + 2 * lane] = a0; wt[dir * 128 + 2 * lane + 1] = a1; wt[256 + dir * 128 + 2 * lane] = __logf(d0) - a0; wt[256 + dir * 128 + 2 * lane + 1] = __logf(d1) - a1;
    LAS float* wv = (LAS float*)(c.lds + SD_WV) + (hl * 2 + dir) * 128;
    wv[2 * lane] = __expf(total - a0) * d0; wv[2 * lane + 1] = __expf(total - a1) * d1;
    if (lane == 0) ((LAS float*)(c.lds + SD_MISC))[hl * 2 + dir] = total;
}

__device__ __forceinline__ void ssd_s1_unit(const Ctx& c, int l, int b, int cidx, int g) {
    int t0, len; const int rowbase = chunk_row(b, cidx, t0, len);
    ssd_conv_stage<false, true>(c, l, g, rowbase, t0, len);
    ssd_scan_stage(c, l, g, rowbase);
    __syncthreads();
    const int tid_l = c.wave * 64 + lane_now();
    const int lane = tid_l & 63, hi = lane >> 5, hl = c.wave >> 1, dir = c.wave & 1, hh = 4 * g + hl;
    const LAS unsigned char* Xb = c.lds + SD_X + hl * 16384 + (4 * hi + ((lane & 15) >> 2)) * 64 + ((lane >> 4) & 1) * 32 + (lane & 3) * 8;
    const LAS unsigned char* Bb = c.lds + SD_B + (4 * hi + ((lane & 15) >> 2)) * 64 + ((lane >> 4) & 1) * 32 + (lane & 3) * 8;
    const LAS float* wv = (const LAS float*)(c.lds + SD_WV) + (hl * 2 + dir) * 128;
    f32x16 acc[2][2];
#pragma unroll
    for (int i = 0; i < 2; ++i) { acc[i][0] = zero16(); acc[i][1] = zero16(); }
#pragma unroll 2
    for (int ks = 0; ks < 8; ++ks) {
        const f32x4 w0 = *(const LAS f32x4*)(wv + 16 * ks + 4 * hi), w1 = *(const LAS f32x4*)(wv + 16 * ks + 8 + 4 * hi);
        bf16x8 xa[2], bb[2];
#pragma unroll
        for (int pt = 0; pt < 2; ++pt) { const s16x4 lo = lds_tr(Xb + pt * 8192 + ks * 1024), hi4 = lds_tr(Xb + pt * 8192 + ks * 1024 + 512);
            u32x4 t; t.x = cvtpk(bf2f((unsigned short)lo[0]) * w0.x, bf2f((unsigned short)lo[1]) * w0.y); t.y = cvtpk(bf2f((unsigned short)lo[2]) * w0.z, bf2f((unsigned short)lo[3]) * w0.w);
            t.z = cvtpk(bf2f((unsigned short)hi4[0]) * w1.x, bf2f((unsigned short)hi4[1]) * w1.y); t.w = cvtpk(bf2f((unsigned short)hi4[2]) * w1.z, bf2f((unsigned short)hi4[3]) * w1.w);
            xa[pt] = __builtin_bit_cast(bf16x8, t); }
#pragma unroll
        for (int nt = 0; nt < 2; ++nt) { const s16x4 lo = lds_tr(Bb + nt * 8192 + ks * 1024), hi4 = lds_tr(Bb + nt * 8192 + ks * 1024 + 512);
            bb[nt] = (bf16x8){lo[0], lo[1], lo[2], lo[3], hi4[0], hi4[1], hi4[2], hi4[3]}; }
#pragma unroll
        for (int pt = 0; pt < 2; ++pt)
#pragma unroll
            for (int nt = 0; nt < 2; ++nt) acc[pt][nt] = __builtin_amdgcn_mfma_f32_32x32x16_bf16(xa[pt], bb[nt], acc[pt][nt], 0, 0, 0);
    }
    float* ST = (float*)(c.ws + WS_ST) + ((((size_t)b * NCH + cidx) * 8 + hh) * 2 + dir) * 4096;
#pragma unroll
    for (int pt = 0; pt < 2; ++pt)
#pragma unroll
        for (int nt = 0; nt < 2; ++nt)
#pragma unroll
            for (int r = 0; r < 16; ++r) ST[(32 * pt + crow(r, hi)) * 64 + 32 * nt + (lane & 31)] = acc[pt][nt][r];
    if (lane == 0) ((float*)(c.ws + WS_TOT))[(((size_t)b * NCH + cidx) * 8 + hh) * 2 + dir] = ((const LAS float*)(c.lds + SD_MISC))[hl * 2 + dir];
    __syncthreads();
}

__device__ __forceinline__ int chain_chunk(int dir, int i) { return dir == 0 ? i : (i == 0 ? 1 : (i == 1 ? 0 : NCH + 1 - i)); }
__device__ __forceinline__ void ssd_s2_item(const Ctx& c, int item) {
    const int half = item & 1, chain = item >> 1, dir = chain & 1, hh = (chain >> 1) & 7, b = chain >> 4;
    const int tid_l = c.wave * 64 + lane_now();
    const int p = 32 * half + (tid_l >> 4), n = 4 * (tid_l & 15);
    const float* ST = (const float*)(c.ws + WS_ST); const float* TOT = (const float*)(c.ws + WS_TOT); bf16_t* PV = (bf16_t*)(c.ws + WS_PREV);
    f32x4 carry = {0.f, 0.f, 0.f, 0.f};
#pragma unroll 6
    for (int i = 0; i < NCH; ++i) { const int cidx = chain_chunk(dir, i); const size_t idx = (((size_t)b * NCH + cidx) * 8 + hh) * 2 + dir;
        const f32x4 s = *(const f32x4*)(ST + idx * 4096 + p * 64 + n); const float dec = __expf(TOT[idx]);
        u32x2 o; o.x = cvtpk(carry.x, carry.y); o.y = cvtpk(carry.z, carry.w); *(u32x2*)(PV + idx * 4096 + p * 64 + n) = o;
        carry = carry * dec + s; }
}

__device__ __forceinline__ void ssd_s3_unit(const Ctx& c, int l, int b, int cidx) {
    const Params& P = *c.P; const bf16_t* U = (const bf16_t*)(c.ws + WS_U); bf16_t* O = (bf16_t*)(c.ws + WS_O);
    int t0, len; const int rowbase = chunk_row(b, cidx, t0, len);
    const int tid_l = c.wave * 64 + lane_now();
    const int lane = tid_l & 63, r32 = lane & 31, hi = lane >> 5, hl = c.wave >> 1, qh2 = c.wave & 1;
#pragma unroll
    for (int g = 0; g < 2; ++g) {
        const int hh = 4 * g + hl;
        MK_TS(c, 1, 0); ssd_conv_stage<true, false>(c, l, g, rowbase, t0, len); MK_TS(c, 1, 1);
        MK_TS(c, 2, 0); ssd_scan_stage(c, l, g, rowbase);
        __syncthreads(); MK_TS(c, 2, 1);
        const LAS float* wt = (const LAS float*)(c.lds + SD_WT) + hl * 512;
        const LAS unsigned char* Xb = c.lds + SD_X + hl * 16384 + (4 * hi + ((lane & 15) >> 2)) * 64 + ((lane >> 4) & 1) * 32 + (lane & 3) * 8;
        const float dsk = P.in[I_SSDD][l * 8 + hh];
#pragma unroll
        for (int qt = 0; qt < 2; ++qt) {
            const int qtg = 2 * qh2 + qt, q = 32 * qtg + r32;
            const LAS unsigned char* cfp = c.lds + SD_C + hi * 2048 + q * 16;
            const float afq = wt[q], abq = wt[128 + q], lwfq = wt[256 + q], lwbq = wt[384 + q];
            f32x16 y[2]; y[0] = zero16(); y[1] = zero16();
            MK_TS(c, 3, 0);
#pragma unroll 1
            for (int jt = 0; jt < 4; ++jt) {
                f32x16 gt = zero16();
#pragma unroll
                for (int s = 0; s < 4; ++s) { const bf16x8 bfr = *(const LAS bf16x8*)(c.lds + SD_B + s * 4096 + hi * 2048 + (32 * jt + r32) * 16);
                    gt = __builtin_amdgcn_mfma_f32_32x32x16_bf16(bfr, *(const LAS bf16x8*)(cfp + s * 4096), gt, 0, 0, 0); }
                if (jt < qtg) {
#pragma unroll
                    for (int r = 0; r < 16; ++r) gt[r] *= __expf(afq + wt[256 + 32 * jt + crow(r, hi)]);
                } else if (jt > qtg) {
#pragma unroll
                    for (int r = 0; r < 16; ++r) gt[r] *= __expf(abq + wt[384 + 32 * jt + crow(r, hi)]);
                } else {
#pragma unroll
                    for (int r = 0; r < 16; ++r) { const int j = 32 * jt + crow(r, hi);
                        const float wv = j < q ? __expf(afq + wt[256 + j]) : (j > q ? __expf(abq + wt[384 + j]) : __expf(afq + lwfq) + __expf(abq + lwbq));
                        gt[r] *= wv; }
                }
                u32x4 m0 = {cvtpk(gt[0], gt[1]), cvtpk(gt[2], gt[3]), cvtpk(gt[4], gt[5]), cvtpk(gt[6], gt[7])}, m1 = {cvtpk(gt[8], gt[9]), cvtpk(gt[10], gt[11]), cvtpk(gt[12], gt[13]), cvtpk(gt[14], gt[15])};
                const bf16x8 pa0 = __builtin_bit_cast(bf16x8, m0), pa1 = __builtin_bit_cast(bf16x8, m1);
#pragma unroll
                for (int pt = 0; pt < 2; ++pt)
#pragma unroll
                    for (int s2 = 0; s2 < 2; ++s2) { const s16x4 lo = lds_tr(Xb + pt * 8192 + (2 * jt + s2) * 1024), h4 = lds_tr(Xb + pt * 8192 + (2 * jt + s2) * 1024 + 512);
                        const bf16x8 xa = {lo[0], lo[1], lo[2], lo[3], h4[0], h4[1], h4[2], h4[3]};
                        y[pt] = __builtin_amdgcn_mfma_f32_32x32x16_bf16(xa, s2 == 0 ? pa0 : pa1, y[pt], 0, 0, 0); }
            }
            MK_TS(c, 3, 1); MK_TS(c, 4, 0);
            const int ql = 64 * qh2 + 32 * qt + r32; const bf16_t* zrow = U + (size_t)(rowbase + ql) * NU + UZ + hh * 64 + 4 * hi;
#pragma unroll 1
            for (int dir = 0; dir < 2; ++dir) { const bf16_t* PV = (const bf16_t*)(c.ws + WS_PREV) + ((((size_t)b * NCH + cidx) * 8 + hh) * 2 + dir) * 4096;
                bf16x8 pf[2][4];
#pragma unroll
                for (int pt = 0; pt < 2; ++pt)
#pragma unroll
                    for (int s = 0; s < 4; ++s) pf[pt][s] = *(const bf16x8*)(PV + (32 * pt + r32) * 64 + 16 * s + 8 * hi);
                const float eq = __expf(dir == 0 ? afq : abq);
#pragma unroll
                for (int pt = 0; pt < 2; ++pt) { f32x16 tmp = zero16();
#pragma unroll
                    for (int s = 0; s < 4; ++s) tmp = __builtin_amdgcn_mfma_f32_32x32x16_bf16(pf[pt][s], *(const LAS bf16x8*)(cfp + s * 4096), tmp, 0, 0, 0);
#pragma unroll
                    for (int r = 0; r < 16; ++r) y[pt][r] += eq * tmp[r]; }
            }
            MK_TS(c, 4, 1); MK_TS(c, 5, 0);
            float ssq = 0.f;
            {
#pragma unroll
              for (int pt = 0; pt < 2; ++pt)
#pragma unroll
                for (int g4 = 0; g4 < 4; ++g4) { const int p0 = 32 * pt + 8 * g4 + 4 * hi;
                    const u32x2 zz_ = *(const u32x2*)(zrow + 32 * pt + 8 * g4);
                    const u32x2 xx = *(const LAS u32x2*)(c.lds + SD_X + hl * 16384 + (p0 >> 5) * 8192 + ql * 64 + (p0 & 31) * 2);
                    float v0 = (y[pt][4 * g4] + dsk * bflo(xx.x)) * silu_f(bflo(zz_.x)), v1 = (y[pt][4 * g4 + 1] + dsk * bfhi(xx.x)) * silu_f(bfhi(zz_.x));
                    float v2 = (y[pt][4 * g4 + 2] + dsk * bflo(xx.y)) * silu_f(bflo(zz_.y)), v3 = (y[pt][4 * g4 + 3] + dsk * bfhi(xx.y)) * silu_f(bfhi(zz_.y));
                    ssq += (v0 * v0 + v1 * v1) + (v2 * v2 + v3 * v3);
                    u32x2 o; o.x = cvtpk(v0, v1); o.y = cvtpk(v2, v3); *(u32x2*)(O + (size_t)(rowbase + ql) * 1024 + 256 + hh * 64 + 4 * hi + 32 * pt + 8 * g4) = o; }
              ssq += __shfl_xor(ssq, 32); if (hi == 0) ((LAS float*)(c.lds + SD_SSQ))[(g * 4 + hl) * 128 + ql] = ssq; }
        }
        MK_TS(c, 5, 1);
        __syncthreads();
    }
    MK_TS(c, 6, 0);
    asm volatile("s_waitcnt vmcnt(0)" ::: "memory");
#pragma unroll
    for (int qt = 0; qt < 2; ++qt) { const int q = 64 * qh2 + 32 * qt + r32; float sq = 0.f;
#pragma unroll
        for (int s8 = 0; s8 < 8; ++s8) sq += ((const LAS float*)(c.lds + SD_SSQ))[s8 * 128 + q];
        const float rstd = __builtin_amdgcn_rsqf(sq * (1.0f / 512.0f) + 1e-6f);
#pragma unroll
        for (int g = 0; g < 2; ++g) { const int hh = 4 * g + hl; const float* ng = P.in[I_SSDG] + l * 512 + hh * 64 + 4 * hi; bf16_t* orow = O + (size_t)(rowbase + q) * 1024 + 256 + hh * 64 + 4 * hi;
            u32x2 v[2][4];
#pragma unroll
            for (int pt = 0; pt < 2; ++pt)
#pragma unroll
                for (int g4 = 0; g4 < 4; ++g4) v[pt][g4] = *(const u32x2*)(orow + 32 * pt + 8 * g4);
#pragma unroll
            for (int pt = 0; pt < 2; ++pt)
#pragma unroll
                for (int g4 = 0; g4 < 4; ++g4) { const f32x4 gg = *(const f32x4*)(ng + 32 * pt + 8 * g4); const u32x2 vv = v[pt][g4];
                    u32x2 o; o.x = cvtpk(bflo(vv.x) * rstd * gg.x, bfhi(vv.x) * rstd * gg.y); o.y = cvtpk(bflo(vv.y) * rstd * gg.z, bfhi(vv.y) * rstd * gg.w);
                    *(u32x2*)(orow + 32 * pt + 8 * g4) = o; } } }
    __syncthreads(); MK_TS(c, 6, 1);
}
}
namespace mk {
constexpr int LC_HIST = 16, LC_BASE = 48, LC_OFF = 80, LC_NT = 120;

__device__ __forceinline__ void router_table_fill(const Ctx& c, int l) {
    const Params& P = *c.P; const int tid_l = c.wave * 64 + lane_now(); LAS f32x4* rw = (LAS f32x4*)c.lds;
    const float* wg = P.in[I_WRG] + (size_t)l * 1024 * 4; const float* we = P.in[I_WRE] + (size_t)l * 1024 * 32;
    __syncthreads();
    for (int i = tid_l; i < 1024 * 9; i += NTHREADS) { const int k = i / 9, q = i % 9; const f32x4 v = q == 0 ? *(const f32x4*)(wg + k * 4) : *(const f32x4*)(we + k * 32 + (q - 1) * 4); rw[q * 1024 + k] = v; }
}
__device__ __forceinline__ void dt_table_fill(const Ctx& c, int l_next) {
    const int tid_l = c.wave * 64 + lane_now(); const float* wdt_g = (const float*)(c.ws + WS_WDT) + (size_t)l_next * 16 * 1024;
    __syncthreads();
    for (int i = tid_l; i < 16 * 256; i += NTHREADS) ((LAS f32x4*)c.lds)[i] = ((const f32x4*)wdt_g)[i];
}
__device__ __forceinline__ void phase_router(const Ctx& c, int l, int nrows, int cnt_slot) {
    const Params& P = *c.P; const float* xw = (const float*)(c.ws + WS_XW); bf16_t* H = (bf16_t*)(c.ws + WS_H);
    const float* mods = (const float*)(c.ws + WS_MODS) + (size_t)l * 9 * 6144;
    const int tid_l = c.wave * 64 + lane_now(); const int lane = tid_l & 63;
    volatile LAS unsigned* lctl = (volatile LAS unsigned*)(c.lds + LDS_CTL_OFF);
    LAS f32x4* rw = (LAS f32x4*)c.lds;
    if (tid_l < 32) lctl[LC_HIST + tid_l] = 0u;
    __syncthreads();
    const float* gf = P.in[I_GFFN] + l * 1024;
    int* SEL = (int*)(c.ws + WS_ROUTE + RT_SEL); int* POS = (int*)(c.ws + WS_ROUTE + RT_POS); float* RW = (float*)(c.ws + WS_ROUTE + RT_W);
    const int gw = c.bid * NWAVES + c.wave, NGW = c.G * NWAVES;
    int my_e0 = 0, my_e1 = 0, my_p0 = 0, my_p1 = 0, nmine = 0;
    for (int row = gw; row < nrows; row += NGW, ++nmine) {
        const int bb = row < NLAT ? row >> 11 : 8; const float* shift = mods + bb * 6144 + 3 * 1024 + lane; const float* scale = mods + bb * 6144 + 4 * 1024 + lane;
        const float* xr = xw + (size_t)row * 1024 + lane; float v[16]; float ss = 0.f;
#pragma unroll
        for (int m = 0; m < 16; ++m) { v[m] = xr[64 * m]; ss += v[m] * v[m]; }
        const float rstd = __builtin_amdgcn_rsqf(wave_sum(ss) * (1.0f / 1024.0f) + 1e-6f);
        bf16_t* hr = H + (size_t)row * 1024 + lane;
#pragma unroll
        for (int m = 0; m < 16; ++m) { v[m] = (v[m] * rstd) * gf[lane + 64 * m] * (scale[64 * m] + 1.0f) + shift[64 * m]; hr[64 * m] = (bf16_t)(cvtpk(v[m], v[m]) & 0xffffu); }
        float acc[36];
#pragma unroll
        for (int q = 0; q < 36; ++q) acc[q] = 0.f;
#pragma unroll
        for (int m = 0; m < 16; ++m) { const float hv = v[m];
#pragma unroll
            for (int q = 0; q < 9; ++q) { const f32x4 w4 = rw[q * 1024 + lane + 64 * m]; acc[4 * q] += hv * w4.x; acc[4 * q + 1] += hv * w4.y; acc[4 * q + 2] += hv * w4.z; acc[4 * q + 3] += hv * w4.w; }
            if (m & 1) __builtin_amdgcn_sched_barrier(0); }
#pragma unroll
        for (int q = 0; q < 4; ++q) acc[q] = wave_sum(acc[q]) + P.in[I_BRG][l * 4 + q];
        float ea[16], eb[16];
#pragma unroll
        for (int q = 0; q < 16; ++q) { ea[q] = acc[4 + q]; eb[q] = acc[20 + q]; }
        const int jd_l = ((lane >> 5) & 1) * 8 + ((lane >> 4) & 1) * 4 + ((lane >> 3) & 1) * 2 + ((lane >> 2) & 1);
        const float ta = reduce16_transposed(ea, lane) + P.in[I_BRE][l * 32 + jd_l], tb = reduce16_transposed(eb, lane) + P.in[I_BRE][l * 32 + 16 + jd_l];
        int gi = 0; float gm = acc[0];
#pragma unroll
        for (int j = 1; j < 4; ++j) if (acc[j] > gm) { gm = acc[j]; gi = j; }
        float gs = 0.f;
#pragma unroll
        for (int j = 0; j < 4; ++j) gs += __expf(acc[j] - gm);
        const float gwt = 1.0f / gs;
        float el[8];
#pragma unroll
        for (int j = 0; j < 8; ++j) { const int jd = (gi & 1) * 8 + j; const int src = ((jd >> 3) & 1) * 32 + ((jd >> 2) & 1) * 16 + ((jd >> 1) & 1) * 8 + (jd & 1) * 4;
            const float fa = __shfl(ta, src), fb = __shfl(tb, src); el[j] = gi >= 2 ? fb : fa; }
        int i0 = 0; float v0 = el[0];
#pragma unroll
        for (int j = 1; j < 8; ++j) if (el[j] > v0) { v0 = el[j]; i0 = j; }
        int i1 = -1; float v1 = 0.f;
#pragma unroll
        for (int j = 0; j < 8; ++j) if (j != i0 && (i1 < 0 || el[j] > v1)) { v1 = el[j]; i1 = j; }
        const float e1 = __expf(v1 - v0); const float w0 = gwt / (1.0f + e1), w1 = gwt * e1 / (1.0f + e1);
        const int ex0 = gi * 8 + i0, ex1 = gi * 8 + i1;
        int lp0 = 0, lp1 = 0;
        if (lane == 0) { lp0 = (int)__hip_atomic_fetch_add((LAS unsigned*)(c.lds + LDS_CTL_OFF) + LC_HIST + ex0, 1u, __ATOMIC_RELAXED, __HIP_MEMORY_SCOPE_WORKGROUP);
                         lp1 = (int)__hip_atomic_fetch_add((LAS unsigned*)(c.lds + LDS_CTL_OFF) + LC_HIST + ex1, 1u, __ATOMIC_RELAXED, __HIP_MEMORY_SCOPE_WORKGROUP);
                         SEL[row * 2] = ex0; SEL[row * 2 + 1] = ex1; RW[row * 2] = w0; RW[row * 2 + 1] = w1; }
        lp0 = __shfl(lp0, 0); lp1 = __shfl(lp1, 0);
        if (lane == nmine) { my_e0 = ex0; my_e1 = ex1; my_p0 = lp0; my_p1 = lp1; }
    }
    __syncthreads();
    unsigned* ctlw = (unsigned*)(c.ws + WS_CTL);
    unsigned* cnt = ctlw + CW_CNT + 64 * cnt_slot; unsigned* pool = ctlw + CW_POOL + 64 * cnt_slot; unsigned* tof = ctlw + CW_TOF + 8192 * cnt_slot;
    int* tile_e = (int*)(c.ws + WS_ROUTE + RT_TILE_E);
    if (tid_l < 32) { const unsigned h = lctl[LC_HIST + tid_l]; unsigned base = 0;
        if (h) { base = __hip_atomic_fetch_add(cnt + tid_l, h, __ATOMIC_RELAXED, __HIP_MEMORY_SCOPE_AGENT);
            for (unsigned j = (base + 255u) >> 8; (j << 8) < base + h; ++j) { const unsigned t = __hip_atomic_fetch_add(pool, 1u, __ATOMIC_RELAXED, __HIP_MEMORY_SCOPE_AGENT);
                tile_e[t] = tid_l; __hip_atomic_store(tof + tid_l * 144 + j, t + 1u, __ATOMIC_RELAXED, __HIP_MEMORY_SCOPE_AGENT); } }
        lctl[LC_BASE + tid_l] = base; }
    __syncthreads();
    int* SLOT = (int*)(c.ws + WS_ROUTE + RT_SLOT); bf16_t* HS = (bf16_t*)(c.ws + WS_U);
    int ms0 = 0, ms1 = 0;
    if (lane < nmine) { const int row = gw + lane * NGW;
        const unsigned p0 = lctl[LC_BASE + my_e0] + (unsigned)my_p0, p1 = lctl[LC_BASE + my_e1] + (unsigned)my_p1;
        unsigned t0 = 0, t1 = 0;
        for (unsigned sp = 0; sp < (1u << 22); ++sp) { if (!t0) t0 = __hip_atomic_load(tof + my_e0 * 144 + (p0 >> 8), __ATOMIC_RELAXED, __HIP_MEMORY_SCOPE_AGENT); if (!t1) t1 = __hip_atomic_load(tof + my_e1 * 144 + (p1 >> 8), __ATOMIC_RELAXED, __HIP_MEMORY_SCOPE_AGENT);
            if (t0 && t1) break; __builtin_amdgcn_s_sleep(1); }
        ms0 = (int)(((t0 ? t0 : 1u) - 1u) * 256u + (p0 & 255u)); ms1 = (int)(((t1 ? t1 : 1u) - 1u) * 256u + (p1 & 255u));
        SLOT[row * 2] = ms0; SLOT[row * 2 + 1] = ms1; }
    asm volatile("s_waitcnt vmcnt(0)" ::: "memory");
    for (int i = 0; i < nmine; ++i) { const int row = gw + i * NGW; const int s0 = __shfl(ms0, i), s1 = __shfl(ms1, i);
        const u32x4* src = (const u32x4*)(H + (size_t)row * 1024) + lane; const u32x4 a = src[0], bq = src[64];
        u32x4* d0 = (u32x4*)(HS + (size_t)s0 * 1024) + lane; u32x4* d1 = (u32x4*)(HS + (size_t)s1 * 1024) + lane;
        d0[0] = a; d0[64] = bq; d1[0] = a; d1[64] = bq; }
    __syncthreads();
}

__device__ __forceinline__ void phase_sort(const Ctx& c, int l, int nrows) {
    const int tid_l = c.wave * 64 + lane_now(); const int lane = tid_l & 63;
    volatile LAS unsigned* lctl = (volatile LAS unsigned*)(c.lds + LDS_CTL_OFF);
    const unsigned* cnt = (const unsigned*)(c.ws + WS_CTL) + CW_CNT + 64 * l;
    int* tile_e = (int*)(c.ws + WS_ROUTE + RT_TILE_E); int* ntl = (int*)(c.ws + WS_ROUTE + RT_NTILES);
    if (tid_l == 0) { unsigned off = 0;
#pragma unroll 1
        for (int e = 0; e < 32; ++e) { const unsigned n = __hip_atomic_load(cnt + e, __ATOMIC_RELAXED, __HIP_MEMORY_SCOPE_AGENT); lctl[LC_OFF + e] = off; const unsigned nt = (n + 255u) >> 8;
            if (c.bid == 0) {
#pragma unroll 1
                for (unsigned t = 0; t < nt; ++t) tile_e[(off >> 8) + t] = e; }
            off += nt << 8; }
        if (c.bid == 0) ntl[0] = (int)(off >> 8); }
    __syncthreads();
    const int* SEL = (const int*)(c.ws + WS_ROUTE + RT_SEL); const int* POS = (const int*)(c.ws + WS_ROUTE + RT_POS); int* SLOT = (int*)(c.ws + WS_ROUTE + RT_SLOT);
    const bf16_t* H = (const bf16_t*)(c.ws + WS_H); bf16_t* HS = (bf16_t*)(c.ws + WS_U);
    const int gw = c.bid * NWAVES + c.wave, NGW = c.G * NWAVES;
    for (int row = gw; row < nrows; row += NGW) {
        const int s0 = (int)lctl[LC_OFF + SEL[row * 2]] + POS[row * 2], s1 = (int)lctl[LC_OFF + SEL[row * 2 + 1]] + POS[row * 2 + 1];
        if (lane == 0) { SLOT[row * 2] = s0; SLOT[row * 2 + 1] = s1; }
        const u32x4* src = (const u32x4*)(H + (size_t)row * 1024) + lane; const u32x4 a = src[0], b = src[64];
        u32x4* d0 = (u32x4*)(HS + (size_t)s0 * 1024) + lane; u32x4* d1 = (u32x4*)(HS + (size_t)s1 * 1024) + lane;
        d0[0] = a; d0[64] = b; d1[0] = a; d1[64] = b;
    }
    __syncthreads();
}

struct CombRow { f32x4 x[4]; u32x2 a[4], b[4]; float w0, w1; int bb; };
__device__ __forceinline__ void comb_load(CombRow& r, int row, int s0, int s1, float w0, float w1, const float* xw, const bf16_t* OS, int lane) {
    r.w0 = w0; r.w1 = w1; r.bb = row < NLAT ? row >> 11 : 8;
#pragma unroll
    for (int j = 0; j < 4; ++j) { r.x[j] = ((const f32x4*)(xw + (size_t)row * 1024))[lane + 64 * j]; r.a[j] = __builtin_nontemporal_load((const u32x2*)(OS + (size_t)s0 * 1024) + lane + 64 * j); r.b[j] = __builtin_nontemporal_load((const u32x2*)(OS + (size_t)s1 * 1024) + lane + 64 * j); }
}
__device__ __forceinline__ void comb_finish(const Ctx& c, CombRow& r, int row, int l, bool last, bool store_x, const LAS float* wdt, int lane) {
    const Params& P = *c.P; float* xw = (float*)(c.ws + WS_XW); const float* mods = (const float*)(c.ws + WS_MODS) + (size_t)l * 9 * 6144;
    const float* gate = mods + r.bb * 6144 + 5 * 1024; f32x4 v[4]; float ss = 0.f;
#pragma unroll
    for (int j = 0; j < 4; ++j) { const f32x4 gg = ((const f32x4*)gate)[lane + 64 * j]; f32x4 x = r.x[j]; const u32x2 a = r.a[j], bq = r.b[j]; const float w0 = r.w0, w1 = r.w1;
        x.x += gg.x * (w0 * bflo(a.x) + w1 * bflo(bq.x)); x.y += gg.y * (w0 * bfhi(a.x) + w1 * bfhi(bq.x)); x.z += gg.z * (w0 * bflo(a.y) + w1 * bflo(bq.y)); x.w += gg.w * (w0 * bfhi(a.y) + w1 * bfhi(bq.y));
        v[j] = x; ss += (x.x * x.x + x.y * x.y) + (x.z * x.z + x.w * x.w); if (!last && store_x) ((f32x4*)(xw + (size_t)row * 1024))[lane + 64 * j] = x; }
    const float rstd = __builtin_amdgcn_rsqf(wave_sum(ss) * (1.0f / 1024.0f) + 1e-6f);
    if (last) {
#pragma unroll
        for (int j = 0; j < 4; ++j) { const f32x4 gg = ((const f32x4*)P.in[I_GFIN])[lane + 64 * j]; ((f32x4*)(P.out + (size_t)row * 1024))[lane + 64 * j] = (v[j] * rstd) * gg; }
    } else {
        const float* modn = (const float*)(c.ws + WS_MODS) + (size_t)(l + 1) * 9 * 6144; bf16_t* H = (bf16_t*)(c.ws + WS_H); float* dtv = (float*)(c.ws + WS_DT);
        const float* g = P.in[I_GMIX] + (l + 1) * 1024; const float* shift = modn + r.bb * 6144; const float* scale = modn + r.bb * 6144 + 1024;
#pragma unroll
        for (int j = 0; j < 4; ++j) { const f32x4 gg = ((const f32x4*)g)[lane + 64 * j], sh = ((const f32x4*)shift)[lane + 64 * j], sl = ((const f32x4*)scale)[lane + 64 * j];
            v[j] = (v[j] * rstd) * gg * (sl + 1.0f) + sh;
            u32x2 o; o.x = cvtpk(v[j].x, v[j].y); o.y = cvtpk(v[j].z, v[j].w); ((u32x2*)(H + (size_t)row * 1024))[lane + 64 * j] = o; }
        float pa[16];
#pragma unroll
        for (int jd = 0; jd < 16; ++jd) { float a = 0.f;
#pragma unroll
            for (int j = 0; j < 4; ++j) { const f32x4 w = ((const LAS f32x4*)(wdt + jd * 1024))[lane + 64 * j]; a += (v[j].x * w.x + v[j].y * w.y) + (v[j].z * w.z + v[j].w * w.w); }
            pa[jd] = a; if ((jd & 3) == 3) __builtin_amdgcn_sched_barrier(0); }
        const float tot = reduce16_transposed(pa, lane); const int jd_l = ((lane >> 5) & 1) * 8 + ((lane >> 4) & 1) * 4 + ((lane >> 3) & 1) * 2 + ((lane >> 2) & 1);
        if ((lane & 3) == 0) dtv[(size_t)row * 16 + jd_l] = softplus_f(tot + P.in[I_DTB][(l + 1) * 16 + jd_l]);
    }
}
__device__ __forceinline__ void phase_combine(const Ctx& c, int l, int nrows, bool store_x) {
    const float* xw = (const float*)(c.ws + WS_XW); const bf16_t* OS = (const bf16_t*)(c.ws + WS_U);
    const int* SLOT = (const int*)(c.ws + WS_ROUTE + RT_SLOT); const float* RW = (const float*)(c.ws + WS_ROUTE + RT_W);
    const int tid_l = c.wave * 64 + lane_now(); const int lane = tid_l & 63;
    const int gw = c.bid * NWAVES + c.wave, NGW = c.G * NWAVES;
    const bool last = (l == DEPTH - 1);
    LAS float* wdt = (LAS float*)c.lds;
    __syncthreads();
    int ms0 = 0, ms1 = 0; float mw0 = 0.f, mw1 = 0.f;
    { const int myrow = gw + lane * NGW; if (myrow < nrows) { ms0 = SLOT[myrow * 2]; ms1 = SLOT[myrow * 2 + 1]; mw0 = RW[myrow * 2]; mw1 = RW[myrow * 2 + 1]; } }
    int row = gw, i = 0;
    for (; row + NGW < nrows; row += 2 * NGW, i += 2) {
        CombRow r0, r1;
        comb_load(r0, row, __shfl(ms0, i), __shfl(ms1, i), __shfl(mw0, i), __shfl(mw1, i), xw, OS, lane);
        comb_load(r1, row + NGW, __shfl(ms0, i + 1), __shfl(ms1, i + 1), __shfl(mw0, i + 1), __shfl(mw1, i + 1), xw, OS, lane);
        comb_finish(c, r0, row, l, last, store_x, wdt, lane); comb_finish(c, r1, row + NGW, l, last, store_x, wdt, lane);
    }
    if (row < nrows) { CombRow r0; comb_load(r0, row, __shfl(ms0, i), __shfl(ms1, i), __shfl(mw0, i), __shfl(mw1, i), xw, OS, lane); comb_finish(c, r0, row, l, last, store_x, wdt, lane); }
}
}
namespace mk {
constexpr int NPH = 10, PH_TOTAL = 2 + DEPTH * NPH;
__global__ void __launch_bounds__(NTHREADS, 2) mk_fwd(Params P, int ph_lo, int ph_hi) {
    extern __shared__ __attribute__((aligned(16))) unsigned char lds_raw[];
    Ctx c0; c0.lds = (LAS unsigned char*)lds_raw; c0.wave = __builtin_amdgcn_readfirstlane((int)threadIdx.x >> 6); c0.G = gridDim.x; c0.bid = blockIdx.x; c0.P = &P; c0.ws = P.ws;
    volatile LAS unsigned* lctl = (volatile LAS unsigned*)(c0.lds + LDS_CTL_OFF);
    if (threadIdx.x < 256) lctl[threadIdx.x] = 0u;
    __syncthreads();
    unsigned* ctl = (unsigned*)(c0.ws + WS_CTL);
    XcdBarrier bar; bar.bar = ctl + CW_BAR; bar.x = 0; bar.st = lctl;
    const bool one_launch = (ph_hi - ph_lo) > 1;
    if (one_launch) bar = xcd_barrier_post(ctl + CW_BAR, lctl);
#ifndef MK_DUP
#define MK_DUP -1
#endif
#define NREP(k) ((MK_DUP >= 0 && (((k) < 2) ? (k) == MK_DUP : (((k) - 2) % NPH) + 2 == MK_DUP)) ? 2 : 1)
#define PH(k) if (ph_lo <= (k) && (k) < ph_hi) for (int rep_ = 0; rep_ < NREP(k); ++rep_, body_end(k))
#define DUMMY(k) (NREP(k) == 2 && rep_ == 0)
#ifndef MK_STAMP
#define MK_STAMP -1
#endif
#ifdef MK_SUB
#define defined_MK_SUB 1
#else
#define defined_MK_SUB 0
#endif
    unsigned long long t_prev = 0ull, t_acc = 0ull; if (MK_STAMP >= 0) t_prev = __builtin_amdgcn_s_memrealtime();
    auto body_end = [&](int k) { if (MK_STAMP >= 100) { asm volatile("s_waitcnt vmcnt(0) lgkmcnt(0)" ::: "memory"); const unsigned long long now_ = __builtin_amdgcn_s_memrealtime(); if ((((k) < 2) ? (k) : (((k) - 2) % NPH) + 2) == (MK_STAMP % 100)) t_acc += now_ - t_prev; } };
#define PTYPE(k) (((k) < 2) ? (k) : (((k) - 2) % NPH) + 2)
#define SEAM(k) do { if (ph_lo <= (k) && (k) + 1 < ph_hi) { xcd_barrier(bar); if (MK_DUP == 100) xcd_barrier(bar); } \
    if (MK_STAMP >= 0) { const unsigned long long now_ = __builtin_amdgcn_s_memrealtime(); if (MK_STAMP < 100 && (PTYPE(k) == MK_STAMP || MK_STAMP == 99)) t_acc += now_ - t_prev; t_prev = now_; } } while (0)
    PH(0) { const Ctx c = fresh(c0); phase_p0a(c); } SEAM(0);
    PH(1) { const Ctx c = fresh(c0); phase_norm1(c, 0, c.P->in[I_X], c.P->in[I_CTX]); } SEAM(1);
    for (int l = 0; l < DEPTH; ++l) {
        const int pb = 2 + l * NPH; const bool need_ctx = l < DEPTH - 1;
        PH(pb + 0) { const Ctx c = fresh(c0);
            pg8::Gemm g{(const pg8::bf16_t*)(c.ws + WS_H), (const pg8::bf16_t*)(c.ws + WS_BT_IN) + (size_t)l * NU * 1024, NT, NU, 1024};
            pg8::StaticOrder So; So.init(NT, NU, c.G, c.bid);
            EpiInProj E{(bf16_t*)(c.ws + WS_U), (const f32x2*)(c.ws + WS_ROPE)};
            pg8::gemm_phase<EpiInProj, pg8::StaticOrder, false>((PG8_LAS unsigned char*)c.lds, g, So, E, nullptr, c.wave);
        } SEAM(pb + 0);
        constexpr int NGQA3 = 32;
        PH(pb + 1) { const Ctx c = fresh(c0);
            for (int i = c.bid; i < 288 + 256 - NGQA3; i += c.G) {
                if (i < 288) { const int b = i / 36, rem = i % 36; ssd_s1_unit(c, l, b, rem >> 1, rem & 1); }
                else { const int k = i - 288; attn_unit<0>(c, l, k >> 5, (k & 31) >> 1, k & 1); } }
        } SEAM(pb + 1);
        PH(pb + 2) { const Ctx c = fresh(c0);
            for (int i = c.bid; i < 256; i += c.G) ssd_s2_item(c, i);
        } SEAM(pb + 2);
        PH(pb + 3) { const Ctx c = fresh(c0);
            const int ns3 = need_ctx ? 144 : 128; const int nrest = NGQA3 + 256 + (need_ctx ? 64 : 0);
            if (c.bid < ns3) { if (need_ctx) ssd_s3_unit(c, l, c.bid / 18, c.bid % 18); else ssd_s3_unit(c, l, c.bid >> 4, 2 + (c.bid & 15)); }
            else if (c.G > ns3) {
                for (int k = c.bid - ns3; k < nrest; k += c.G - ns3) {
                    if (k < NGQA3) { const int k0 = 256 - NGQA3 + k; attn_unit<0>(c, l, k0 >> 5, (k0 & 31) >> 1, k0 & 1); }
                    else if (k < NGQA3 + 256) { const int k1 = k - NGQA3; attn_unit<1>(c, l, k1 >> 5, (k1 & 31) >> 2, k1 & 3); }
                    else { const int k2 = k - NGQA3 - 256; attn_unit<2>(c, l, k2 >> 3, k2 & 7, 0); } } }
        } SEAM(pb + 3);
        PH(pb + 4) { const Ctx c = fresh(c0);
            pg8::Gemm g{(const pg8::bf16_t*)(c.ws + WS_O), (const pg8::bf16_t*)(c.ws + WS_BT_OUT) + (size_t)l * 1024 * 1024, NLAT, 1024, 1024};
            pg8::StaticOrder So; So.init(NLAT, 1024, c.G, c.bid);
            float* xw = (float*)(c.ws + WS_XW); const float* xlat = l == 0 ? c.P->in[I_X] : xw; const float* xctx = l == 0 ? c.P->in[I_CTX] : xw + (size_t)NLAT * 1024;
            EpiOutProj E{xlat, xctx, DUMMY(pb + 4) ? (float*)(c.ws + WS_U) : xw, (const float*)(c.ws + WS_MODS) + (size_t)l * 9 * 6144};
            pg8::gemm_phase<EpiOutProj, pg8::StaticOrder, false>((PG8_LAS unsigned char*)c.lds, g, So, E, nullptr, c.wave);
            if (need_ctx && !DUMMY(pb + 4)) for (int t = c.bid; t < 256; t += c.G) ctx_outproj_tile(c, l, t);
            router_table_fill(c, l);
        } SEAM(pb + 4);
        const int nrows = need_ctx ? NT : NLAT;
        PH(pb + 5) { const Ctx c = fresh(c0); phase_router(c, l, nrows, DUMMY(pb + 5) ? l + 4 : l); } SEAM(pb + 5);
        PH(pb + 7) { const Ctx c = fresh(c0);
            const int ntiles = __builtin_amdgcn_readfirstlane((int)__hip_atomic_load((const unsigned*)(c.ws + WS_CTL) + CW_POOL + 64 * l, __ATOMIC_RELAXED, __HIP_MEMORY_SCOPE_AGENT));
            pg8::Gemm g{(const pg8::bf16_t*)(c.ws + WS_U), (const pg8::bf16_t*)(c.ws + WS_BT_GU) + (size_t)l * 32 * 512 * 1024, ntiles * 256, 512, 1024};
            ExpertOrder<2> So{(const int*)(c.ws + WS_ROUTE + RT_TILE_E), ntiles, c.G, c.bid};
            EpiGateUp E{(bf16_t*)(c.ws + WS_HID)};
            pg8::gemm_phase<EpiGateUp, ExpertOrder<2>, false>((PG8_LAS unsigned char*)c.lds, g, So, E, nullptr, c.wave);
        } SEAM(pb + 7);
        PH(pb + 8) { const Ctx c = fresh(c0);
            const int ntiles = __builtin_amdgcn_readfirstlane((int)__hip_atomic_load((const unsigned*)(c.ws + WS_CTL) + CW_POOL + 64 * l, __ATOMIC_RELAXED, __HIP_MEMORY_SCOPE_AGENT));
            pg8::Gemm g{(const pg8::bf16_t*)(c.ws + WS_HID), (const pg8::bf16_t*)(c.ws + WS_BT_DN) + (size_t)l * 32 * 1024 * 256, ntiles * 256, 1024, 256};
            ExpertOrder<4> So{(const int*)(c.ws + WS_ROUTE + RT_TILE_E), ntiles, c.G, c.bid};
            EpiDown E{(bf16_t*)(c.ws + WS_U)};
            pg8::gemm_phase<EpiDown, ExpertOrder<4>, false>((PG8_LAS unsigned char*)c.lds, g, So, E, nullptr, c.wave);
            if (l + 1 < DEPTH) dt_table_fill(c, l + 1);
        } SEAM(pb + 8);
        PH(pb + 9) { const Ctx c = fresh(c0); phase_combine(c, l, nrows, !DUMMY(pb + 9)); } SEAM(pb + 9);
    }
#ifdef MK_SUB
    if (c0.bid == 0) { __syncthreads(); t_acc = *(volatile LAS unsigned long long*)(c0.lds + LDS_CTL_OFF + 512 + 8); }
#endif
    if ((MK_STAMP >= 0 || defined_MK_SUB) && c0.bid == (MK_STAMP >= 200 ? (int)gridDim.x - 1 : 0)) { const unsigned long long t0 = __builtin_amdgcn_s_memrealtime(); while (__builtin_amdgcn_s_memrealtime() - t0 < t_acc) __builtin_amdgcn_s_sleep(8); }
#undef PH
#undef SEAM
}

static int g_grid = 0;
static void mk_setup() {
    if (g_grid) return;
    int dev = 0, cus = 0; hipGetDevice(&dev); hipDeviceGetAttribute(&cus, hipDeviceAttributeMultiprocessorCount, dev);
    if (hipFuncSetAttribute((const void*)mk_fwd, hipFuncAttributeMaxDynamicSharedMemorySize, LDS_BYTES) != hipSuccess) { fprintf(stderr, "hipFuncSetAttribute failed\n"); g_grid = -1; return; }
    int per_cu = 0; (void)hipOccupancyMaxActiveBlocksPerMultiprocessor(&per_cu, (const void*)mk_fwd, NTHREADS, LDS_BYTES); (void)hipGetLastError();
    g_grid = cus;
}
static void mk_launch(const Params& P, int lo, int hi, hipStream_t stream) {
    hipLaunchKernelGGL(mk_fwd, dim3(g_grid), dim3(NTHREADS), LDS_BYTES, stream, P, lo, hi);
}
}

extern "C" void kernel_launch(void* const* d_in, const int* in_sizes, int n_in, void* d_out, int out_size, void* d_ws, size_t ws_size, hipStream_t stream) {
    mk::mk_setup(); if (mk::g_grid <= 0) return;
    if (ws_size < mk::WS_END) { fprintf(stderr, "workspace too small\n"); return; }
    unsigned char* ws = (unsigned char*)d_ws;
    hipMemsetAsync(ws + mk::WS_CTL, 0, mk::CTL_BYTES, stream);
    mk::Params MP{}; for (int i = 0; i < 26; ++i) MP.in[i] = (const float*)d_in[i]; MP.out = (float*)d_out; MP.ws = ws;
    mk::mk_launch(MP, 0, mk::PH_TOTAL, stream);
}
```

```cpp
#include <hip/hip_runtime.h>
#include <cstdio>
#include <cstdint>
#include <math.h>
#define XB_TMO      128
#define XB_XCNT(j)  (256  + 64 * (j))
#define XB_XSUB(j)  (1280 + 64 * (j))
#define XB_XGEN(j)  (2304 + 64 * (j))
#define XB_TOP      3328
#define XB_TOPGEN   3392
#define XCD_BAR_WORDS 3456
#define XB_SPIN_CAP (1u << 18)
#define LAS __attribute__((address_space(3)))

__device__ __forceinline__ unsigned xb_ld(unsigned* p)              { return __hip_atomic_load(p, __ATOMIC_RELAXED, __HIP_MEMORY_SCOPE_AGENT); }
__device__ __forceinline__ unsigned xb_add(unsigned* p, unsigned v) { return __hip_atomic_fetch_add(p, v, __ATOMIC_RELAXED, __HIP_MEMORY_SCOPE_AGENT); }
__device__ __forceinline__ unsigned xb_xcc_id() { return (unsigned)__builtin_amdgcn_s_getreg((3 << 11) | 20) & 0xFu; }
#define XB_SPIN(cond, bar) do { unsigned _sp = 0; while (cond) { __builtin_amdgcn_s_sleep(1); \
    if ((++_sp & 255u) == 0u) { if (xb_ld(&(bar)[XB_TMO])) break; if (_sp > XB_SPIN_CAP) { atomicAdd(&(bar)[XB_TMO], 1u); break; } } } } while (0)

struct XcdBarrier {
    unsigned* bar; unsigned x;
    volatile LAS unsigned* st;
};

__device__ __forceinline__ XcdBarrier xcd_barrier_post(unsigned* bar, volatile LAS unsigned* st) {
    XcdBarrier b; b.bar = bar; b.x = xb_xcc_id(); b.st = st;
    if (threadIdx.x == 0) (void)xb_add(&bar[XB_XCNT(b.x)], 1u);
    return b;
}
__device__ __forceinline__ void xcd_barrier_complete(unsigned* bar, unsigned x, unsigned& nloc, unsigned& nx) {
    const unsigned G = gridDim.x * gridDim.y * gridDim.z;
    unsigned sum, cnt, mine, sp = 0u;
    for (;;) {
        sum = 0u; cnt = 0u; mine = 0u;
#pragma unroll
        for (unsigned j = 0; j < 16; ++j) { const unsigned c = xb_ld(&bar[XB_XCNT(j)]); sum += c; cnt += (c > 0u) ? 1u : 0u; mine = (j == x) ? c : mine; }
        if (sum == G) break;
        __builtin_amdgcn_s_sleep(1);
        if ((++sp & 255u) == 0u) { if (xb_ld(&bar[XB_TMO])) break; if (sp > XB_SPIN_CAP) { atomicAdd(&bar[XB_TMO], 1u); break; } }
    }
    nloc = mine > 0u ? mine : 1u; nx = cnt > 0u ? cnt : 1u;
}

__device__ __forceinline__ void xcd_barrier(const XcdBarrier& b) {
    asm volatile("s_waitcnt vmcnt(0)" ::: "memory");
    __syncthreads();
    if (threadIdx.x == 0) {
        unsigned* bar = b.bar;
        __builtin_amdgcn_s_waitcnt(0);
        unsigned nloc = b.st[0], nx = b.st[1];
        if (nloc == 0u) { xcd_barrier_complete(bar, b.x, nloc, nx); b.st[0] = nloc; b.st[1] = nx; }
        const unsigned old = xb_add(&bar[XB_XSUB(b.x)], 1u);
        const unsigned gen = old / nloc;
        if (old + 1u == (gen + 1u) * nloc) {
            __builtin_amdgcn_fence(__ATOMIC_RELEASE, "agent");
            asm volatile("s_waitcnt vmcnt(0)" ::: "memory");
            const unsigned og = xb_add(&bar[XB_TOP], 1u);
            const unsigned tg = og / nx;
            if (og + 1u == (tg + 1u) * nx) xb_add(&bar[XB_TOPGEN], 1u);
            else XB_SPIN(xb_ld(&bar[XB_TOPGEN]) == tg, bar);
            __builtin_amdgcn_fence(__ATOMIC_ACQUIRE, "agent");
            xb_add(&bar[XB_XGEN(b.x)], 1u);
            asm volatile("s_waitcnt vmcnt(0)" ::: "memory");
        } else {
            XB_SPIN(xb_ld(&bar[XB_XGEN(b.x)]) == gen, bar);
            __builtin_amdgcn_fence(__ATOMIC_ACQUIRE, "agent");
            asm volatile("s_waitcnt vmcnt(0)" ::: "memory");
        }
    }
    __syncthreads();
}

namespace pg8 {
#define PG8_LAS __attribute__((address_space(3)))
typedef unsigned short bf16_t;
typedef short bf16x8 __attribute__((ext_vector_type(8)));
typedef float f32x4 __attribute__((ext_vector_type(4)));
typedef unsigned u32x4 __attribute__((ext_vector_type(4)));
constexpr int BM = 256, BK = 64, HALF = 128, HTB = HALF * BK * 2  , STAGE_BYTES = 8 * HTB, NXCD = 8, WGM = 8;

__host__ __device__ __forceinline__ int lds_byte(int r, int c) { const int st = (r >> 4) * 2 + (c >> 5), rr = r & 15, cc = c & 31, ob = rr * 64 + cc * 2; return st * 1024 + (ob ^ (((ob >> 9) & 1) << 5)); }
__host__ __device__ __forceinline__ void stage_rc(int b, int& R, int& C) { const int st = b / 1024, sb = b % 1024, swz = sb ^ (((sb >> 9) & 1) << 5); R = (st >> 1) * 16 + swz / 64; C = (st & 1) * 32 + (swz % 64) / 2; }
__host__ __device__ __forceinline__ int perm32(int rho) { const int n = rho >> 4, i = rho & 15; return 8 * (i >> 2) + 4 * n + (i & 3); }

struct Unit { int pm, pn; };
struct Gemm { const bf16_t* A; const bf16_t* Bt; int M, N, K; };

struct StaticOrder {
    int nM, nN, nwg, G, c;
    __host__ __device__ void init(int M, int N, int G_, int c_) { nM = M / BM; nN = N / BM; nwg = nM * nN; G = G_; c = c_; }
    __host__ __device__ bool next(int i, Unit& u) const {
        const long L = (long)i * G + c; if (L >= nwg) return false;
        int wgid = (int)L; { const int q = nwg / NXCD, r = nwg % NXCD, xcd = wgid % NXCD, off = wgid / NXCD; wgid = (xcd < r ? xcd * (q + 1) : r * (q + 1) + (xcd - r) * q) + off; }
        const int nig = WGM * nN, gid = wgid / nig, fm = gid * WGM, gsz = (nM - fm) < WGM ? (nM - fm) : WGM;
        u.pm = fm + ((wgid % nig) % gsz); u.pn = (wgid % nig) / gsz; return true;
    }
    __device__ __forceinline__ void a_ready(const Unit&) const {}
    __device__ __forceinline__ void done(const Unit&) const {}
};
__device__ __forceinline__ unsigned cvt_pk_bf16(float lo, float hi) { unsigned r; asm volatile("v_cvt_pk_bf16_f32 %0, %1, %2" : "=v"(r) : "v"(lo), "v"(hi)); return r; }
typedef float f32x2 __attribute__((ext_vector_type(2)));
template <class Epi, class Sched, bool STAMP = false>
__device__ __forceinline__ void gemm_phase(PG8_LAS unsigned char* lds, const Gemm g, const Sched& S, const Epi& E, unsigned long long* stamps, const int wid  ) {
    int lane_; asm volatile("v_mbcnt_lo_u32_b32 %0, -1, 0\n\tv_mbcnt_hi_u32_b32 %0, -1, %0" : "=v"(lane_));
    const int lane = lane_, tid = wid * 64 + lane, wr = wid >> 2, wc = wid & 3, fr = lane & 15, fq = lane >> 4;
    const int K = g.K, nt = K / BK;
    int ts_lo = 0, ts_hi = 0, nts = 0; const unsigned long long rt_entry = STAMP ? (unsigned long long)wall_clock64() : 0ull;
#define PG8_STAMP() do { if (STAMP && wid == 0 && nts < 64) { const unsigned long long _c = (unsigned long long)clock64(); \
        ts_lo = (lane == nts) ? (int)(unsigned)_c : ts_lo; ts_hi = (lane == nts) ? (int)(unsigned)(_c >> 32) : ts_hi; ++nts; } } while (0)
    PG8_STAMP();
    unsigned voffA[2], voffB[2];
#pragma unroll
    for (int i = 0; i < 2; ++i) { int R, C; stage_rc(tid * 16 + i * 8192, R, C); const int Rb = Epi::PERM ? ((R & ~31) + perm32(R & 31)) : R;
        voffA[i] = (unsigned)(R * K + C) * 2u; voffB[i] = (unsigned)(Rb * K + C) * 2u; }
    const size_t kstep = (size_t)(BK * 2);
    const size_t hstep = (size_t)HALF * K * 2;
    const size_t tstep = 2 * hstep;
    const unsigned ldsw = (unsigned)wid * 1024u;
    const int aoff = lds_byte(wr * 64 + fr, fq * 8), boff = lds_byte(wc * 32 + fr, fq * 8);
#define PG8_SA(b, h) (((b) * 2 + (h)) * HTB)
#define PG8_SB(b, h) ((4 + (b) * 2 + (h)) * HTB)
#define PG8_STAGE(bufoff, gbase, voff) do { _Pragma("unroll") for (int _i = 0; _i < 2; ++_i) \
        __builtin_amdgcn_global_load_lds((const unsigned*)((const char*)(gbase) + (voff)[_i]), (PG8_LAS unsigned*)(lds + (bufoff) + ldsw + _i * 8192), 16, 0, 0); } while (0)
#define PG8_LDA(dst, b, h) do { _Pragma("unroll") for (int m = 0; m < 4; ++m) _Pragma("unroll") for (int k = 0; k < 2; ++k) dst[m][k] = *(const PG8_LAS bf16x8*)(lds + PG8_SA(b, h) + aoff + m * 2048 + k * 1024); } while (0)
#define PG8_LDB(dst, b, h) do { _Pragma("unroll") for (int n = 0; n < 2; ++n) _Pragma("unroll") for (int k = 0; k < 2; ++k) dst[n][k] = *(const PG8_LAS bf16x8*)(lds + PG8_SB(b, h) + boff + n * 2048 + k * 1024); } while (0)
#define PG8_MMA(ai, bj, At, Bt) do { __builtin_amdgcn_s_setprio(1); _Pragma("unroll") for (int m = 0; m < 4; ++m) _Pragma("unroll") for (int n = 0; n < 2; ++n) _Pragma("unroll") for (int k = 0; k < 2; ++k) \
        acc[ai][bj][m][n] = __builtin_amdgcn_mfma_f32_16x16x32_bf16(Bt[n][k], At[m][k], acc[ai][bj][m][n], 0, 0, 0); __builtin_amdgcn_s_setprio(0); } while (0)
#define PG8_WAIT_V(n) asm volatile("s_waitcnt vmcnt(" #n ")" ::: "memory")
#define PG8_WAIT_L(n) asm volatile("s_waitcnt lgkmcnt(" #n ")" ::: "memory")
#define PG8_BAR __builtin_amdgcn_s_barrier()
#define PG8_SCHED __builtin_amdgcn_sched_barrier(0)
    Unit cur, nxt; int ui = 0;
    if (!S.next(0, cur)) return;
    f32x4 acc[2][2][4][2];
#pragma unroll
    for (int a = 0; a < 2; ++a)
#pragma unroll
        for (int b = 0; b < 2; ++b)
#pragma unroll
            for (int m = 0; m < 4; ++m)
#pragma unroll
                for (int n = 0; n < 2; ++n) acc[a][b][m][n] = (f32x4){0.f, 0.f, 0.f, 0.f};
    bf16x8 At[4][2], B0[2][2], B1[2][2];
    const char* cA = (const char*)g.A + (size_t)cur.pm * tstep; const char* cB = (const char*)g.Bt + (size_t)cur.pn * tstep;
    S.a_ready(cur);
    PG8_STAGE(PG8_SB(0, 0), cB, voffB); PG8_STAGE(PG8_SA(0, 0), cA, voffA); PG8_STAGE(PG8_SB(0, 1), cB + hstep, voffB); PG8_STAGE(PG8_SA(0, 1), cA + hstep, voffA);
    if (wr == 1) PG8_BAR;
    PG8_WAIT_V(4); PG8_BAR;
    PG8_STAGE(PG8_SB(1, 0), cB + kstep, voffB); PG8_STAGE(PG8_SA(1, 0), cA + kstep, voffA); PG8_STAGE(PG8_SB(1, 1), cB + hstep + kstep, voffB);
    PG8_WAIT_V(6); PG8_BAR;
    PG8_STAMP();
    for (;;) {
        const bool has_next = S.next(ui + 1, nxt);
        const char* nA = has_next ? (const char*)g.A + (size_t)nxt.pm * tstep : cA; const char* nB = has_next ? (const char*)g.Bt + (size_t)nxt.pn * tstep : cB;
        for (int t = 0; t < nt; t += 2) {
            const bool last = (t == nt - 2);
            const char* a1 = cA + (size_t)(t + 1) * kstep;
            const char* a2 = last ? nA : cA + (size_t)(t + 2) * kstep; const char* b2 = last ? nB : cB + (size_t)(t + 2) * kstep;
            const char* a3 = a2 + kstep; const char* b3 = b2 + kstep;
            if (last && has_next) S.a_ready(nxt);
            PG8_LDB(B0, 0, 0); PG8_SCHED; PG8_LDA(At, 0, 0); PG8_STAGE(PG8_SA(1, 1), a1 + hstep, voffA);
            PG8_WAIT_L(8); PG8_BAR; PG8_WAIT_L(0); PG8_MMA(0, 0, At, B0); PG8_BAR; PG8_SCHED;
            PG8_LDB(B1, 0, 1); PG8_STAGE(PG8_SB(0, 0), b2, voffB);
            PG8_BAR; PG8_WAIT_L(0); PG8_MMA(0, 1, At, B1); PG8_BAR;
            PG8_LDA(At, 0, 1); PG8_STAGE(PG8_SA(0, 0), a2, voffA);
            PG8_BAR; PG8_WAIT_L(0); PG8_MMA(1, 0, At, B0); PG8_BAR; PG8_SCHED;
            PG8_STAGE(PG8_SB(0, 1), b2 + hstep, voffB);
            PG8_WAIT_V(6); PG8_BAR; PG8_MMA(1, 1, At, B1); PG8_BAR;
            PG8_LDB(B0, 1, 0); PG8_SCHED; PG8_LDA(At, 1, 0); PG8_STAGE(PG8_SA(0, 1), a2 + hstep, voffA);
            PG8_WAIT_L(8); PG8_BAR; PG8_WAIT_L(0); PG8_MMA(0, 0, At, B0); PG8_BAR; PG8_SCHED;
            PG8_LDB(B1, 1, 1); PG8_STAGE(PG8_SB(1, 0), b3, voffB);
            PG8_BAR; PG8_WAIT_L(0); PG8_MMA(0, 1, At, B1); PG8_BAR;
            PG8_LDA(At, 1, 1); PG8_STAGE(PG8_SA(1, 0), a3, voffA);
            PG8_BAR; PG8_WAIT_L(0); PG8_MMA(1, 0, At, B0); PG8_BAR; PG8_SCHED;
            PG8_STAGE(PG8_SB(1, 1), b3 + hstep, voffB);
            PG8_WAIT_V(6); PG8_BAR; PG8_MMA(1, 1, At, B1); PG8_BAR;
        }
        PG8_STAMP();
        if constexpr (!Epi::AFTER_DRAIN) { E(acc, cur, wr, wc, fr, fq); S.done(cur); }
        PG8_STAMP();
        if (!has_next) break;
#pragma unroll
        for (int a = 0; a < 2; ++a)
#pragma unroll
            for (int b = 0; b < 2; ++b)
#pragma unroll
                for (int m = 0; m < 4; ++m)
#pragma unroll
                    for (int n = 0; n < 2; ++n) acc[a][b][m][n] = (f32x4){0.f, 0.f, 0.f, 0.f};
        cur = nxt; cA = nA; cB = nB; ++ui;
    }
    PG8_WAIT_V(0);
    if (wr == 0) PG8_BAR;
    PG8_BAR;
    if constexpr (Epi::AFTER_DRAIN) { E.fused(acc, cur, wr, wc, fr, fq, lds, wid, lane); S.done(cur); }
    PG8_STAMP();
    if (STAMP && wid == 0) { stamps[lane] = lane < nts ? (((unsigned long long)(unsigned)ts_hi << 32) | (unsigned)ts_lo) : 0ull;
        if (lane == 62) stamps[62] = rt_entry; if (lane == 63) stamps[63] = (unsigned long long)wall_clock64(); }
#undef PG8_STAMP
#undef PG8_SA
#undef PG8_SB
#undef PG8_STAGE
#undef PG8_LDA
#undef PG8_LDB
#undef PG8_MMA
#undef PG8_WAIT_V
#undef PG8_WAIT_L
#undef PG8_BAR
#undef PG8_SCHED
}
}

namespace mk {
constexpr int D = 1024, NB = 8, S = 2048, L = 256, DEPTH = 4;
constexpr int NLAT = NB * S, NCTX = NB * L, NT = NLAT + NCTX;
constexpr int NIN = 2576;
constexpr int NU = 2560;
constexpr int UQ_A = 0, UK_A = 256, UV_A = 384, UZ = 512, UX = 1024, UB = 1536, UC = 1664, UQ_N = 1792, UK_N = 2048, UV_N = 2304;
constexpr int NEXP = 32, DE = 256;
constexpr int MAXSLOT = 45056;
constexpr int MAXTILE = MAXSLOT / 256;
constexpr int NCH = 18;
constexpr int NWAVES = 8, NTHREADS = 512;

typedef unsigned short bf16_t;
typedef short bf16x8 __attribute__((ext_vector_type(8)));
typedef short s16x4 __attribute__((ext_vector_type(4)));
typedef float f32x4 __attribute__((ext_vector_type(4)));
typedef float f32x2 __attribute__((ext_vector_type(2)));
typedef float f32x16 __attribute__((ext_vector_type(16)));
typedef unsigned u32x4 __attribute__((ext_vector_type(4)));
typedef unsigned u32x2 __attribute__((ext_vector_type(2)));

constexpr size_t MiB = 1u << 20;
constexpr size_t WS_CTL = 0, CTL_BYTES = 1 * MiB;
constexpr size_t WS_MODS = 1 * MiB;
constexpr size_t WS_ROPE = 2 * MiB;
constexpr size_t WS_WDT = 2 * MiB + 65536;
constexpr size_t WS_ROUTE = 3 * MiB;
constexpr size_t WS_DT = 5 * MiB;
constexpr size_t WS_BT_IN = 8 * MiB;
constexpr size_t WS_BT_OUT = 28 * MiB;
constexpr size_t WS_BT_GU = 36 * MiB;
constexpr size_t WS_BT_DN = 164 * MiB;
constexpr size_t WS_XW = 228 * MiB;
constexpr size_t WS_H = 300 * MiB;
constexpr size_t WS_U = 336 * MiB;
constexpr size_t WS_O = 426 * MiB;
constexpr size_t WS_HID = 462 * MiB;
constexpr size_t WS_ST = 484 * MiB;
constexpr size_t WS_PREV = 520 * MiB;
constexpr size_t WS_TOT = 538 * MiB;
constexpr size_t WS_END = 539 * MiB;
constexpr size_t RT_SEL = 0;
constexpr size_t RT_POS = 192 * 1024;
constexpr size_t RT_W = 384 * 1024;
constexpr size_t RT_SLOT = 576 * 1024;
constexpr size_t RT_TILE_E = 768 * 1024;
constexpr size_t RT_NTILES = 768 * 1024 + 4096;
constexpr int CW_BAR = 4096, CW_CNT = 16384, CW_POOL = 20480  , CW_TOF = 32768  ;

constexpr int LDS_SCRATCH = 147456;
constexpr int LDS_CTL_OFF = LDS_SCRATCH;
constexpr int LDS_BYTES = LDS_SCRATCH + 1024;

struct Params { const float* in[26]; float* out; unsigned char* ws; };
enum { I_X = 0, I_C, I_CTX, I_CCTX, I_WMOD, I_BMOD, I_GMIX, I_WIN, I_SINK, I_CONVW, I_CONVB, I_DTB, I_ALOG, I_SSDD, I_SSDG, I_RPB, I_WOUT, I_GFFN,
       I_WRG, I_BRG, I_WRE, I_BRE, I_WEG, I_WEU, I_WED, I_GFIN };

__device__ __forceinline__ unsigned f2bf(float f) { unsigned u = __builtin_bit_cast(unsigned, f); return (u + 0x7fffu + ((u >> 16) & 1u)) >> 16; }
__device__ __forceinline__ unsigned pk2(float lo, float hi) { return f2bf(lo) | (f2bf(hi) << 16); }
__device__ __forceinline__ float bf2f(unsigned short b) { return __builtin_bit_cast(float, ((unsigned)b) << 16); }
__device__ __forceinline__ float bflo(unsigned w) { return __builtin_bit_cast(float, w << 16); }
__device__ __forceinline__ float bfhi(unsigned w) { return __builtin_bit_cast(float, w & 0xffff0000u); }
__device__ __forceinline__ float wave_sum(float v) {
#pragma unroll
    for (int o = 1; o < 64; o <<= 1) v += __shfl_xor(v, o);
    return v;
}
__device__ __forceinline__ unsigned cvtpk(float lo, float hi) { typedef __bf16 bf16x2_t __attribute__((ext_vector_type(2))); f32x2 v = {lo, hi}; bf16x2_t b = __builtin_convertvector(v, bf16x2_t); return __builtin_bit_cast(unsigned, b); }
__device__ __forceinline__ float reduce16_transposed(float (&a)[16], int lane) {
    const bool b5 = lane & 32, b4 = lane & 16, b3 = lane & 8, b2 = lane & 4;
    float v8[8];
#pragma unroll
    for (int i = 0; i < 8; ++i) { const float keep = b5 ? a[i + 8] : a[i], send = b5 ? a[i] : a[i + 8]; v8[i] = keep + __shfl_xor(send, 32); }
    float v4[4];
#pragma unroll
    for (int i = 0; i < 4; ++i) { const float keep = b4 ? v8[i + 4] : v8[i], send = b4 ? v8[i] : v8[i + 4]; v4[i] = keep + __shfl_xor(send, 16); }
    float v2[2];
#pragma unroll
    for (int i = 0; i < 2; ++i) { const float keep = b3 ? v4[i + 2] : v4[i], send = b3 ? v4[i] : v4[i + 2]; v2[i] = keep + __shfl_xor(send, 8); }
    float v1; { const float keep = b2 ? v2[1] : v2[0], send = b2 ? v2[0] : v2[1]; v1 = keep + __shfl_xor(send, 4); }
    v1 += __shfl_xor(v1, 2); v1 += __shfl_xor(v1, 1);
    return v1;
}
__device__ __forceinline__ float silu_f(float x) { return x * __builtin_amdgcn_rcpf(1.0f + __expf(-x)); }
__device__ __forceinline__ float softplus_f(float t) { const float x = __expf(t); const float s = x < 0.01f ? x * (1.0f - x * (0.5f - x * (1.0f / 3.0f))) : __logf(1.0f + x); return t > 20.f ? t : s; }
__device__ __forceinline__ int lane_now() { int l; asm volatile("v_mbcnt_lo_u32_b32 %0, -1, 0\n\tv_mbcnt_hi_u32_b32 %0, -1, %0" : "=v"(l)); return l; }
#ifdef MK_SUB
#define MK_TS(c, k, end) do { if ((k) == MK_SUB && (c).bid == 0) { asm volatile("s_waitcnt vmcnt(0) lgkmcnt(0)" ::: "memory"); if ((c).wave == 0 && lane_now() == 0) { volatile LAS unsigned long long* tw = (volatile LAS unsigned long long*)((c).lds + LDS_CTL_OFF + 512); \
    const unsigned long long now_ = __builtin_amdgcn_s_memrealtime(); if (end) tw[1] += now_ - tw[0]; else tw[0] = now_; } } } while (0)
#else
#define MK_TS(c, k, end) do {} while (0)
#endif
#define LDS_WAIT() asm volatile("s_waitcnt lgkmcnt(0)" ::: "memory")
#define VM_WAIT() asm volatile("s_waitcnt vmcnt(0)" ::: "memory")
}
namespace mk {
struct Ctx {
    LAS unsigned char* lds; int wave, G, bid;
    const Params* P; unsigned char* ws;
};

__device__ __forceinline__ Ctx fresh(const Ctx& c) {
    Ctx n = c; asm volatile("" : "+s"(n.wave), "+s"(n.G), "+s"(n.bid));
    { __attribute__((address_space(1))) unsigned char* g = (__attribute__((address_space(1))) unsigned char*)n.ws; asm volatile("" : "+s"(g)); n.ws = (unsigned char*)g; }
    return n; }
__device__ __forceinline__ void tr_item(const float* W, size_t ldw, bf16_t* dst, size_t ldd, int k0, LAS float* scr, int lane) {
#pragma unroll 8
    for (int i = 0; i < 32; ++i) { const int kk = 2 * i + (lane >> 5); scr[kk * 33 + (lane & 31)] = __builtin_nontemporal_load(W + (size_t)(k0 + kk) * ldw + (lane & 31)); }
    LDS_WAIT(); asm volatile("" ::: "memory");
    const int c = lane & 7;
#pragma unroll
    for (int j = 0; j < 4; ++j) { const int n = (lane >> 3) + 8 * j; const LAS float* s = scr + (8 * c) * 33 + n;
        u32x4 o; o.x = cvtpk(s[0 * 33], s[1 * 33]); o.y = cvtpk(s[2 * 33], s[3 * 33]); o.z = cvtpk(s[4 * 33], s[5 * 33]); o.w = cvtpk(s[6 * 33], s[7 * 33]);
        __builtin_nontemporal_store(o, (u32x4*)(dst + (size_t)n * ldd + k0 + 8 * c)); }
    LDS_WAIT(); asm volatile("" ::: "memory");
}

__device__ __forceinline__ void convert_layer(const Ctx& c, int l, int scr_off) {
    const Params& P = *c.P; const int lane = lane_now();
    LAS float* scr = (LAS float*)(c.lds + scr_off + c.wave * 8448);
    const int gw = c.bid * NWAVES + c.wave, NGW = c.G * NWAVES;
    constexpr int IT_IN = 16 * 80, IT_OUT = 16 * 32, IT_G = 32 * 16 * 8, IT_D = 32 * 4 * 32, IT_L = IT_IN + IT_OUT + 2 * IT_G + IT_D;
    bf16_t* bt_in = (bf16_t*)(c.ws + WS_BT_IN); bf16_t* bt_out = (bf16_t*)(c.ws + WS_BT_OUT); bf16_t* bt_gu = (bf16_t*)(c.ws + WS_BT_GU); bf16_t* bt_dn = (bf16_t*)(c.ws + WS_BT_DN);
    for (int it = gw; it < IT_L; it += NGW) {
        int r = it;
        if (r < IT_IN) { const int kb = r / 80, nb = r % 80; const int n0 = nb * 32, ns = n0 < 1792 ? n0 : n0 + 16;
            tr_item(P.in[I_WIN] + (size_t)l * 1024 * NIN + ns, NIN, bt_in + ((size_t)l * NU + n0) * 1024, 1024, kb * 64, scr, lane); continue; }
        r -= IT_IN;
        if (r < IT_OUT) { const int kb = r / 32, nb = r % 32;
            tr_item(P.in[I_WOUT] + (size_t)l * 1024 * 1024 + nb * 32, 1024, bt_out + ((size_t)l * 1024 + nb * 32) * 1024, 1024, kb * 64, scr, lane); continue; }
        r -= IT_OUT;
        if (r < 2 * IT_G) { const int up = r >= IT_G; if (up) r -= IT_G; const int e = r / 128, q = r % 128, kb = q / 8, nb = q % 8; const int f0 = nb * 32;
            const float* src = P.in[up ? I_WEU : I_WEG] + ((size_t)(l * 32 + e) * 1024) * 256 + f0;
            bf16_t* dst = bt_gu + (((size_t)(l * 32 + e) * 2 + (f0 >> 7)) * 256 + (up ? 128 : 0) + (f0 & 127)) * 1024;
            tr_item(src, 256, dst, 1024, kb * 64, scr, lane); continue; }
        r -= 2 * IT_G;
        { const int e = r / 128, q = r % 128, kb = q / 32, nb = q % 32;
            tr_item(P.in[I_WED] + ((size_t)(l * 32 + e) * 256) * 1024 + nb * 32, 1024, bt_dn + ((size_t)(l * 32 + e) * 1024 + nb * 32) * 256, 256, kb * 64, scr, lane); }
    }
}

__device__ __forceinline__ void phase_p0a(const Ctx& c) {
    const Params& P = *c.P; const int c_lane = lane_now(), c_tid = c.wave * 64 + c_lane;
    LAS float* sc = (LAS float*)c.lds;
    LAS float* red = (LAS float*)(c.lds + 36864);
    for (int i = c_tid; i < 9 * 1024; i += NTHREADS) { const int bb = i >> 10, k = i & 1023; const float v = bb < 8 ? P.in[I_C][bb * 1024 + k] : P.in[I_CCTX][k]; sc[i] = silu_f(v); }
    __syncthreads();
    float* mods = (float*)(c.ws + WS_MODS);
    for (int bi = c.bid; bi < DEPTH * 96; bi += c.G) {
        const int l = bi / 96, n = (bi % 96) * 64 + c_lane;
        const float* w = P.in[I_WMOD] + (size_t)l * 1024 * 6144 + n;
        float acc[9];
#pragma unroll
        for (int bb = 0; bb < 9; ++bb) acc[bb] = 0.f;
        const int kb = c.wave * 128;
#pragma unroll 8
        for (int k = 0; k < 128; ++k) { const float wv = __builtin_nontemporal_load(w + (size_t)(kb + k) * 6144);
#pragma unroll
            for (int bb = 0; bb < 9; ++bb) acc[bb] += sc[bb * 1024 + kb + k] * wv; }
#pragma unroll
        for (int bb = 0; bb < 9; ++bb) red[(c.wave * 9 + bb) * 64 + c_lane] = acc[bb];
        __syncthreads();
        for (int i = c_tid; i < 9 * 64; i += NTHREADS) { const int bb = i >> 6, ln = i & 63; float s = 0.f;
#pragma unroll
            for (int w8 = 0; w8 < 8; ++w8) s += red[(w8 * 9 + bb) * 64 + ln];
            const int nn = (bi % 96) * 64 + ln;
            mods[((size_t)l * 9 + bb) * 6144 + nn] = s + P.in[I_BMOD][l * 6144 + nn]; }
        __syncthreads();
    }
    const int gt = c.bid * NTHREADS + c_tid, NGT = c.G * NTHREADS;
    { f32x2* rope = (f32x2*)(c.ws + WS_ROPE);
      for (int i = gt; i < 64 * 16; i += NGT) { const int pos = i >> 4, fi = i & 15; const float inv = 1.0f / powf(10000.0f, (float)(2 * fi) / 32.0f); const float ang = (float)pos * inv;
          rope[i] = (f32x2){cosf(ang), sinf(ang)}; }
      float* wdt = (float*)(c.ws + WS_WDT);
      for (int i = gt; i < DEPTH * 16 * 1024; i += NGT) { const int k = i & 1023, jd = (i >> 10) & 15, l = i >> 14; wdt[i] = P.in[I_WIN][((size_t)l * 1024 + k) * NIN + 1792 + jd]; } }
    for (int l = 0; l < DEPTH; ++l) convert_layer(c, l, 36864 + 18432);
}

__device__ __forceinline__ void norm_row(const float* xrow, const float* g, const float* shift, const float* scale, bf16_t* hrow, const LAS float* wdt, const float* dtb, float* dtrow, int lane) {
    const f32x4* xr = (const f32x4*)xrow + lane; f32x4 v[4]; float ss = 0.f;
#pragma unroll
    for (int j = 0; j < 4; ++j) { v[j] = xr[64 * j]; ss += (v[j].x * v[j].x + v[j].y * v[j].y) + (v[j].z * v[j].z + v[j].w * v[j].w); }
    const float rstd = __builtin_amdgcn_rsqf(wave_sum(ss) * (1.0f / 1024.0f) + 1e-6f);
#pragma unroll
    for (int j = 0; j < 4; ++j) { const f32x4 gg = ((const f32x4*)g)[lane + 64 * j], sh = ((const f32x4*)shift)[lane + 64 * j], sl = ((const f32x4*)scale)[lane + 64 * j];
        v[j] = (v[j] * rstd) * gg * (sl + 1.0f) + sh;
        u32x2 o; o.x = cvtpk(v[j].x, v[j].y); o.y = cvtpk(v[j].z, v[j].w); ((u32x2*)hrow)[lane + 64 * j] = o; }
    {
        float pa[16];
#pragma unroll
        for (int jd = 0; jd < 16; ++jd) { float a = 0.f;
#pragma unroll
            for (int j = 0; j < 4; ++j) { const f32x4 w = ((const LAS f32x4*)(wdt + jd * 1024))[lane + 64 * j]; a += (v[j].x * w.x + v[j].y * w.y) + (v[j].z * w.z + v[j].w * w.w); }
            pa[jd] = a; if ((jd & 3) == 3) __builtin_amdgcn_sched_barrier(0); }
        const float tot = reduce16_transposed(pa, lane); const int jd_l = ((lane >> 5) & 1) * 8 + ((lane >> 4) & 1) * 4 + ((lane >> 3) & 1) * 2 + ((lane >> 2) & 1);
        if ((lane & 3) == 0) dtrow[jd_l] = softplus_f(tot + dtb[jd_l]);
    }
}
__device__ __forceinline__ void phase_norm1(const Ctx& c, int l, const float* xlat, const float* xctx) {
    const Params& P = *c.P; const float* mods = (const float*)(c.ws + WS_MODS) + (size_t)l * 9 * 6144;
    bf16_t* H = (bf16_t*)(c.ws + WS_H); float* dtv = (float*)(c.ws + WS_DT); const float* wdt_g = (const float*)(c.ws + WS_WDT) + (size_t)l * 16 * 1024;
    const int gw = c.bid * NWAVES + c.wave, NGW = c.G * NWAVES; const int c_lane = lane_now();
    LAS float* wdt = (LAS float*)c.lds;
    for (int i = c.wave * 64 + c_lane; i < 16 * 256; i += NTHREADS) ((LAS f32x4*)wdt)[i] = ((const f32x4*)wdt_g)[i];
    __syncthreads();
    for (int row = gw; row < NT; row += NGW) {
        const int bb = row < NLAT ? row >> 11 : 8; const float* xr = row < NLAT ? xlat + (size_t)row * 1024 : xctx + (size_t)(row - NLAT) * 1024;
        norm_row(xr, P.in[I_GMIX] + l * 1024, mods + bb * 6144, mods + bb * 6144 + 1024, H + (size_t)row * 1024, wdt, P.in[I_DTB] + l * 16, dtv + (size_t)row * 16, c_lane);
    }
}

constexpr float QSCALE_Q = 0.125f * 1.4426950408889634f;
struct EpiInProj {
    static constexpr bool PERM = false, AFTER_DRAIN = false;
    bf16_t* U; const f32x2* rope;
    __device__ __forceinline__ void operator()(const pg8::f32x4 (&acc)[2][2][4][2], const pg8::Unit& u, int wr, int wc, int fr, int fq) const {
        const int row0 = u.pm * 256 + wr * 64 + fr, col0 = u.pn * 256 + wc * 32 + 4 * fq;
#pragma unroll
        for (int bj = 0; bj < 2; ++bj) {
            const int cb = u.pn * 256 + bj * 128 + wc * 32;
            const bool do_rope = (u.pm < 64) && (cb < 384); const bool is_q = (cb < 256) || (cb >= 1792 && cb < 2048);
#pragma unroll
            for (int ai = 0; ai < 2; ++ai)
#pragma unroll
                for (int m = 0; m < 4; ++m) {
                    const int row = row0 + ai * 128 + m * 16;
                    pg8::f32x4 x1 = acc[ai][bj][m][0], x2 = acc[ai][bj][m][1];
                    if (do_rope) { const int t = row & 2047; const int pos = ((cb >> 5) & 1) ? (t & 63) : (t >> 6);
                        const f32x4* rp = (const f32x4*)(rope + pos * 16 + 4 * fq); const f32x4 r0 = rp[0], r1 = rp[1];
                        const pg8::f32x4 cs = {r0.x, r0.z, r1.x, r1.z}, sn = {r0.y, r0.w, r1.y, r1.w};
                        const pg8::f32x4 y1 = x1 * cs - x2 * sn, y2 = x2 * cs + x1 * sn; x1 = y1; x2 = y2; }
                    if (is_q) { x1 = x1 * QSCALE_Q; x2 = x2 * QSCALE_Q; }
                    bf16_t* rowp = U + (size_t)row * NU + col0 + bj * 128;
                    u32x2 o1, o2; o1.x = cvtpk(x1[0], x1[1]); o1.y = cvtpk(x1[2], x1[3]); o2.x = cvtpk(x2[0], x2[1]); o2.y = cvtpk(x2[2], x2[3]);
                    *(u32x2*)rowp = o1; *(u32x2*)(rowp + 16) = o2;
                }
        }
    }
};
struct EpiOutProj {
    static constexpr bool PERM = false, AFTER_DRAIN = false;
    const float* xlat; const float* xctx; bf16_t* xw; const float* mods_l; int from_input;
    __device__ __forceinline__ void operator()(const pg8::f32x4 (&acc)[2][2][4][2], const pg8::Unit& u, int wr, int wc, int fr, int fq) const {
        const int row0 = u.pm * 256 + wr * 64 + fr, col0 = u.pn * 256 + wc * 32 + 4 * fq;
        const int bb = u.pm < 64 ? (u.pm >> 3) : 8; const float* gate = mods_l + bb * 6144 + 2 * 1024;
        const float* src = u.pm < 64 ? xlat : xctx - (size_t)NLAT * 1024;
        f32x4 gv[2][2];
#pragma unroll
        for (int bj = 0; bj < 2; ++bj)
#pragma unroll
            for (int n = 0; n < 2; ++n) gv[bj][n] = *(const f32x4*)(gate + col0 + bj * 128 + n * 16);
#pragma unroll
        for (int ai = 0; ai < 2; ++ai)
#pragma unroll
            for (int m = 0; m < 4; ++m) { const size_t off = (size_t)(row0 + ai * 128 + m * 16) * 1024 + col0;
#pragma unroll
                for (int bj = 0; bj < 2; ++bj)
#pragma unroll
                    for (int n = 0; n < 2; ++n) { f32x4 xo;
                        if (from_input) xo = *(const f32x4*)(src + off + bj * 128 + n * 16);
                        else { const u32x2 xb = *(const u32x2*)(xw + off + bj * 128 + n * 16); xo.x = bflo(xb.x); xo.y = bfhi(xb.x); xo.z = bflo(xb.y); xo.w = bfhi(xb.y); }
                        const pg8::f32x4 a = acc[ai][bj][m][n];
                        u32x2 r; r.x = cvtpk(xo.x + gv[bj][n].x * a[0], xo.y + gv[bj][n].y * a[1]); r.y = cvtpk(xo.z + gv[bj][n].z * a[2], xo.w + gv[bj][n].w * a[3]);
                        *(u32x2*)(xw + off + bj * 128 + n * 16) = r; } }
    }
};
struct EpiGateUp {
    static constexpr bool PERM = false, AFTER_DRAIN = false;
    bf16_t* HID;
    __device__ __forceinline__ void operator()(const pg8::f32x4 (&acc)[2][2][4][2], const pg8::Unit& u, int wr, int wc, int fr, int fq) const {
        const int row0 = u.pm * 256 + wr * 64 + fr, col0 = (u.pn & 1) * 128 + wc * 32 + 4 * fq;
#pragma unroll
        for (int ai = 0; ai < 2; ++ai)
#pragma unroll
            for (int m = 0; m < 4; ++m) { bf16_t* rowp = HID + (size_t)(row0 + ai * 128 + m * 16) * 256 + col0;
#pragma unroll
                for (int n = 0; n < 2; ++n) { const pg8::f32x4 g = acc[ai][0][m][n], up = acc[ai][1][m][n]; float h[4];
#pragma unroll
                    for (int i = 0; i < 4; ++i) h[i] = g[i] * __builtin_amdgcn_rcpf(1.0f + __expf(-g[i])) * up[i];
                    u32x2 o; o.x = cvtpk(h[0], h[1]); o.y = cvtpk(h[2], h[3]); *(u32x2*)(rowp + n * 16) = o; } }
    }
};
struct EpiDown {
    static constexpr bool PERM = false, AFTER_DRAIN = false;
    bf16_t* OUT;
    __device__ __forceinline__ void operator()(const pg8::f32x4 (&acc)[2][2][4][2], const pg8::Unit& u, int wr, int wc, int fr, int fq) const {
        const int row0 = u.pm * 256 + wr * 64 + fr, col0 = (u.pn & 3) * 256 + wc * 32 + 4 * fq;
#pragma unroll
        for (int ai = 0; ai < 2; ++ai)
#pragma unroll
            for (int m = 0; m < 4; ++m) { bf16_t* rowp = OUT + (size_t)(row0 + ai * 128 + m * 16) * 1024 + col0;
#pragma unroll
                for (int bj = 0; bj < 2; ++bj)
#pragma unroll
                    for (int n = 0; n < 2; ++n) { const pg8::f32x4 a = acc[ai][bj][m][n]; u32x2 o; o.x = cvtpk(a[0], a[1]); o.y = cvtpk(a[2], a[3]); *(u32x2*)(rowp + bj * 128 + n * 16) = o; } }
    }
};
template <int NSUB> struct ExpertOrder {
    const int* tile_e; int ntiles, G, c;
    __device__ __forceinline__ bool next(int i, pg8::Unit& u) const {
        const long Lx = (long)i * G + c; if (Lx >= (long)ntiles * NSUB) return false;
        const int tile = (int)(Lx / NSUB), sub = (int)(Lx % NSUB); u.pm = tile; u.pn = __builtin_amdgcn_readfirstlane(tile_e[tile]) * NSUB + sub; return true; }
    __device__ __forceinline__ void a_ready(const pg8::Unit&) const {}
    __device__ __forceinline__ void done(const pg8::Unit&) const {}
};
}
namespace mk {
__device__ __forceinline__ int crow(int r, int hi) { return (r & 3) + 8 * (r >> 2) + 4 * hi; }
typedef short v4i16_t __attribute__((ext_vector_type(4)));
__device__ __forceinline__ s16x4 lds_tr(const LAS unsigned char* p) { return __builtin_bit_cast(s16x4, __builtin_amdgcn_ds_read_tr16_b64_v4i16((LAS v4i16_t*)p)); }

__device__ __forceinline__ f32x16 zero16() { f32x16 z;
#pragma unroll
    for (int r = 0; r < 16; ++r) z[r] = 0.f;
    asm volatile("" : "+v"(z)); return z; }
constexpr int AT_K = 0, AT_V = 16384, AT_BIAS = 32768, AT_BYTES = 32768 + 2048;
constexpr float LOG2E = 1.4426950408889634f, QSCALE = 0.125f * 1.4426950408889634f;

template <int TYPE> __device__ __forceinline__ void attn_unit(const Ctx& c, int l, int ua, int ub, int uc) {
    const Params& P = *c.P; const bf16_t* U = (const bf16_t*)(c.ws + WS_U); bf16_t* O = (bf16_t*)(c.ws + WS_O);
    const int tid_l = c.wave * 64 + lane_now();
    const int lane = tid_l & 63, w = c.wave, r32 = lane & 31, hi = lane >> 5;
    LAS unsigned char* lds = c.lds;
    int b = ua, qrow, qcol, ocol, kcol, vcol, ntl, ntiles; float sinkv = 0.f; bool has_sink = false;
    int qpos = 0, kpos_base = 0;
    int qr = 0, qc = 0, rmin = 0, rs_w = 0, cs_q = 0, rs_q = 0, ks = 0;
    if (TYPE == 0) { const int n = ub, g = uc; const int qh = 2 * g + (w >> 2); qpos = n * 128 + (w & 3) * 32 + r32; qrow = b * S + qpos; qcol = UQ_A + qh * 64; ocol = qh * 64; kcol = UK_A + g * 64; vcol = UV_A + g * 64;
        kpos_base = n * 128 - 128; ntl = 6; has_sink = true; sinkv = P.in[I_SINK][l * 4 + qh]; }
    else if (TYPE == 1) { const int rg = ub, h = uc; qr = 4 * rg + 2 * (w >> 2) + (r32 >> 4); qc = 16 * (w & 3) + (r32 & 15); qrow = b * S + qr * 64 + qc; qcol = UQ_N + h * 64; ocol = 768 + h * 64; kcol = UK_N + h * 64; vcol = UV_N + h * 64;
        int r0 = 4 * rg - 4; if (r0 < 0) r0 = 0; if (r0 > 24) r0 = 24; rmin = r0; int r1 = 4 * rg + 3 - 4; if (r1 < 0) r1 = 0; if (r1 > 24) r1 = 24; ntl = r1 + 8 - rmin;
        rs_q = qr - 4; if (rs_q < 0) rs_q = 0; if (rs_q > 24) rs_q = 24; cs_q = qc - 8; if (cs_q < 0) cs_q = 0; if (cs_q > 48) cs_q = 48;
        { const int r0w = 4 * rg + 2 * (w >> 2); rs_w = r0w - 4; if (rs_w < 0) rs_w = 0; if (rs_w > 24) rs_w = 24; const int cb = w & 3; ks = cb == 0 ? 0 : (cb == 1 ? 8 : (cb == 2 ? 24 : 32)); } }
    else { const int hh = ub; qrow = NLAT + b * L + w * 32 + r32; ntl = 0;
        if (hh < 4) { qcol = UQ_A + hh * 64; ocol = hh * 64; kcol = UK_A + (hh >> 1) * 64; vcol = UV_A + (hh >> 1) * 64; has_sink = true; sinkv = P.in[I_SINK][l * 4 + hh]; }
        else { const int h = hh - 4; qcol = UQ_N + h * 64; ocol = 768 + h * 64; kcol = UK_N + h * 64; vcol = UV_N + h * 64; } }
    ntiles = ntl + 4;
    if (TYPE == 1) { LAS float* bt = (LAS float*)(lds + AT_BIAS); const float* src = P.in[I_RPB] + (size_t)(l * 4 + uc) * 465; for (int i = tid_l; i < 465; i += NTHREADS) bt[i] = src[i] * LOG2E; }
    bf16x8 qf[4];
#pragma unroll
    for (int d0 = 0; d0 < 4; ++d0) qf[d0] = *(const bf16x8*)(U + (size_t)qrow * NU + qcol + d0 * 16 + hi * 8);
    f32x16 o0 = zero16(), o1 = zero16(); float m = -1e30f, lsum = 0.f;
    auto tile_row = [&](int t) -> int {
        if (t >= ntl) return NLAT + b * L + (t - ntl) * 64;
        if (TYPE == 0) { const int kp = kpos_base + 64 * t; return (kp < 0 || kp >= S) ? -1 : b * S + kp; }
        if (TYPE == 1) return b * S + (rmin + t) * 64;
        return -1; };
    auto stage = [&](int t, int slot) {
        const int kr0 = tile_row(t); if (kr0 < 0) return;
        const bf16_t* ks = U + (size_t)(kr0 + lane) * NU + kcol + 8 * w;
        const bf16_t* vs = U + (size_t)(kr0 + 16 * (w & 3) + (lane >> 2)) * NU + vcol + (w >> 2) * 32 + (lane & 3) * 8;
        __builtin_amdgcn_global_load_lds((const unsigned*)ks, (LAS unsigned*)(lds + AT_K + slot * 8192 + w * 1024), 16, 0, 0);
        __builtin_amdgcn_global_load_lds((const unsigned*)vs, (LAS unsigned*)(lds + AT_V + slot * 8192 + w * 1024), 16, 0, 0); };
    stage(0, 0);
    for (int t = 0; t < ntiles; ++t) {
        VM_WAIT(); __syncthreads();
        if (t + 1 < ntiles) stage(t + 1, (t + 1) & 1);
        const int kr0 = tile_row(t);
        bool active = kr0 >= 0; int maskmode = 0;
        if (t < ntl) {
            if (TYPE == 0) { const int q0 = qpos - r32, k0 = kpos_base + 64 * t;
                const int dmin = (k0 > q0 + 31) ? k0 - (q0 + 31) : ((q0 > k0 + 63) ? q0 - (k0 + 63) : 0);
                const int dmax = (q0 + 31 - k0) > (k0 + 63 - q0) ? (q0 + 31 - k0) : (k0 + 63 - q0);
                if (dmin > 128) active = false; maskmode = dmax > 128 ? 1 : 0; }
            if (TYPE == 1) { const int kr = rmin + t; if (kr < rs_w || kr > rs_w + 8) active = false; maskmode = 1; }
        }
        if (TYPE == 1 && active && t < ntl) {
            const int kr = rmin + t;
            const LAS unsigned char* Ks = lds + AT_K + (t & 1) * 8192 + hi * 1024 + (ks + r32) * 16;
            f32x16 p0 = zero16();
#pragma unroll
            for (int d0 = 0; d0 < 4; ++d0) p0 = __builtin_amdgcn_mfma_f32_32x32x16_bf16(*(const LAS bf16x8*)(Ks + d0 * 2048), qf[d0], p0, 0, 0, 0);
            const bool rowok = (unsigned)(kr - rs_q) < 8u;
            const LAS float* bt = (const LAS float*)(lds + AT_BIAS) + (kr - qr + 7) * 31 - qc + 15 + ks;
            float rm = -1e30f;
#pragma unroll
            for (int r = 0; r < 16; ++r) { const int kc = ks + crow(r, hi); const bool v0 = rowok && (unsigned)(kc - cs_q) < 16u; const float b0 = v0 ? bt[crow(r, hi)] : 0.f;
                p0[r] = v0 ? p0[r] + b0 : -1e30f; rm = fmaxf(rm, p0[r]); }
            rm = fmaxf(rm, __shfl_xor(rm, 32));
            const float mn = fmaxf(m, rm); const float alpha = __builtin_amdgcn_exp2f(m - mn); m = mn;
            float ps = 0.f;
#pragma unroll
            for (int r = 0; r < 16; ++r) { p0[r] = p0[r] > -1e29f ? __builtin_amdgcn_exp2f(p0[r] - mn) : 0.f; ps += p0[r]; }
            lsum = lsum * alpha + ps;
#pragma unroll
            for (int r = 0; r < 16; ++r) { o0[r] *= alpha; o1[r] *= alpha; }
            u32x4 t0 = {cvtpk(p0[0], p0[1]), cvtpk(p0[2], p0[3]), cvtpk(p0[4], p0[5]), cvtpk(p0[6], p0[7])}, t1 = {cvtpk(p0[8], p0[9]), cvtpk(p0[10], p0[11]), cvtpk(p0[12], p0[13]), cvtpk(p0[14], p0[15])};
            const bf16x8 pa0 = __builtin_bit_cast(bf16x8, t0), pa1 = __builtin_bit_cast(bf16x8, t1);
            const LAS unsigned char* Vs = lds + AT_V + (t & 1) * 8192 + (ks + 4 * hi + ((lane & 15) >> 2)) * 64 + ((lane >> 4) & 1) * 32 + (lane & 3) * 8;
#pragma unroll
            for (int s2 = 0; s2 < 2; ++s2) {
                const s16x4 a0 = lds_tr(Vs + s2 * 1024), a1 = lds_tr(Vs + s2 * 1024 + 512), b0 = lds_tr(Vs + 4096 + s2 * 1024), b1 = lds_tr(Vs + 4096 + s2 * 1024 + 512);
                const bf16x8 v0 = {a0[0], a0[1], a0[2], a0[3], a1[0], a1[1], a1[2], a1[3]}, v1 = {b0[0], b0[1], b0[2], b0[3], b1[0], b1[1], b1[2], b1[3]};
                o0 = __builtin_amdgcn_mfma_f32_32x32x16_bf16(v0, s2 == 0 ? pa0 : pa1, o0, 0, 0, 0); o1 = __builtin_amdgcn_mfma_f32_32x32x16_bf16(v1, s2 == 0 ? pa0 : pa1, o1, 0, 0, 0); }
        } else
        if (active) {
            const LAS unsigned char* Ks = lds + AT_K + (t & 1) * 8192 + hi * 1024 + r32 * 16;
            f32x16 p0 = zero16(), p1 = zero16();
#pragma unroll
            for (int d0 = 0; d0 < 4; ++d0) { const bf16x8 k0f = *(const LAS bf16x8*)(Ks + d0 * 2048), k1f = *(const LAS bf16x8*)(Ks + d0 * 2048 + 512);
                p0 = __builtin_amdgcn_mfma_f32_32x32x16_bf16(k0f, qf[d0], p0, 0, 0, 0); p1 = __builtin_amdgcn_mfma_f32_32x32x16_bf16(k1f, qf[d0], p1, 0, 0, 0); }
            if (maskmode == 0) {
#pragma unroll
                for (int r = 0; r < 16; ++r) { }
            } else if (TYPE == 0) { const int kb = kpos_base + 64 * t;
#pragma unroll
                for (int r = 0; r < 16; ++r) { const int k0 = kb + crow(r, hi), k1 = k0 + 32; int d0 = qpos - k0; d0 = d0 < 0 ? -d0 : d0; int d1 = qpos - k1; d1 = d1 < 0 ? -d1 : d1;
                    p0[r] = d0 <= 128 ? p0[r] : -1e30f; p1[r] = d1 <= 128 ? p1[r] : -1e30f; }
            } else if (TYPE == 1) { const LAS float* bt = (const LAS float*)(lds + AT_BIAS) + (rmin + t - qr + 7) * 31 - qc + 15;
#pragma unroll
                for (int r = 0; r < 16; ++r) { const int k0 = crow(r, hi), k1 = k0 + 32; const bool v0 = (unsigned)(k0 - cs_q) < 16u, v1 = (unsigned)(k1 - cs_q) < 16u;
                    const float b0 = v0 ? bt[k0] : 0.f, b1 = v1 ? bt[k1] : 0.f;
                    p0[r] = v0 ? p0[r] + b0 : -1e30f; p1[r] = v1 ? p1[r] + b1 : -1e30f; }
            }
            float rm = fmaxf(p0[0], p1[0]);
#pragma unroll
            for (int r = 1; r < 16; ++r) rm = fmaxf(rm, fmaxf(p0[r], p1[r]));
            rm = fmaxf(rm, __shfl_xor(rm, 32));
            const float mn = fmaxf(m, rm); const float alpha = __builtin_amdgcn_exp2f(m - mn); m = mn;
            float ps = 0.f;
            if (maskmode == 0) {
#pragma unroll
                for (int r = 0; r < 16; ++r) { p0[r] = __builtin_amdgcn_exp2f(p0[r] - mn); p1[r] = __builtin_amdgcn_exp2f(p1[r] - mn); ps += p0[r] + p1[r]; }
            } else {
#pragma unroll
                for (int r = 0; r < 16; ++r) { p0[r] = p0[r] > -1e29f ? __builtin_amdgcn_exp2f(p0[r] - mn) : 0.f; p1[r] = p1[r] > -1e29f ? __builtin_amdgcn_exp2f(p1[r] - mn) : 0.f; ps += p0[r] + p1[r]; }
            }
            lsum = lsum * alpha + ps;
#pragma unroll
            for (int r = 0; r < 16; ++r) { o0[r] *= alpha; o1[r] *= alpha; }
            bf16x8 pa[4];
            { u32x4 t0 = {cvtpk(p0[0], p0[1]), cvtpk(p0[2], p0[3]), cvtpk(p0[4], p0[5]), cvtpk(p0[6], p0[7])}; pa[0] = __builtin_bit_cast(bf16x8, t0);
              u32x4 t1 = {cvtpk(p0[8], p0[9]), cvtpk(p0[10], p0[11]), cvtpk(p0[12], p0[13]), cvtpk(p0[14], p0[15])}; pa[1] = __builtin_bit_cast(bf16x8, t1);
              u32x4 t2 = {cvtpk(p1[0], p1[1]), cvtpk(p1[2], p1[3]), cvtpk(p1[4], p1[5]), cvtpk(p1[6], p1[7])}; pa[2] = __builtin_bit_cast(bf16x8, t2);
              u32x4 t3 = {cvtpk(p1[8], p1[9]), cvtpk(p1[10], p1[11]), cvtpk(p1[12], p1[13]), cvtpk(p1[14], p1[15])}; pa[3] = __builtin_bit_cast(bf16x8, t3); }
            const LAS unsigned char* Vs = lds + AT_V + (t & 1) * 8192 + (4 * hi + ((lane & 15) >> 2)) * 64 + ((lane >> 4) & 1) * 32 + (lane & 3) * 8;
#pragma unroll
            for (int ks = 0; ks < 4; ++ks) {
                const s16x4 a0 = lds_tr(Vs + ks * 1024), a1 = lds_tr(Vs + ks * 1024 + 512), b0 = lds_tr(Vs + 4096 + ks * 1024), b1 = lds_tr(Vs + 4096 + ks * 1024 + 512);
                const bf16x8 v0 = {a0[0], a0[1], a0[2], a0[3], a1[0], a1[1], a1[2], a1[3]}, v1 = {b0[0], b0[1], b0[2], b0[3], b1[0], b1[1], b1[2], b1[3]};
                o0 = __builtin_amdgcn_mfma_f32_32x32x16_bf16(v0, pa[ks], o0, 0, 0, 0); o1 = __builtin_amdgcn_mfma_f32_32x32x16_bf16(v1, pa[ks], o1, 0, 0, 0); }
        }
    }
    lsum += __shfl_xor(lsum, 32);
    if (has_sink) { const float s2 = sinkv * LOG2E; const float mn = fmaxf(m, s2); const float alpha = __builtin_amdgcn_exp2f(m - mn); lsum = lsum * alpha + __builtin_amdgcn_exp2f(s2 - mn);
#pragma unroll
        for (int r = 0; r < 16; ++r) { o0[r] *= alpha; o1[r] *= alpha; } }
    const float il = 1.0f / lsum;
    bf16_t* orow = O + (size_t)qrow * 1024 + ocol + 4 * hi;
#pragma unroll
    for (int g4 = 0; g4 < 4; ++g4) { u32x2 a, bq; a.x = cvtpk(o0[4 * g4] * il, o0[4 * g4 + 1] * il); a.y = cvtpk(o0[4 * g4 + 2] * il, o0[4 * g4 + 3] * il);
        bq.x = cvtpk(o1[4 * g4] * il, o1[4 * g4 + 1] * il); bq.y = cvtpk(o1[4 * g4 + 2] * il, o1[4 * g4 + 3] * il);
        *(u32x2*)(orow + 8 * g4) = a; *(u32x2*)(orow + 32 + 8 * g4) = bq; }
    VM_WAIT(); __syncthreads();
}

__device__ __forceinline__ void ctx_outproj_tile(const Ctx& c, int l, int tile) {
    const int lane = lane_now(), r32 = lane & 31, hi = lane >> 5, w = c.wave;
    const int r0 = 64 * (tile >> 3) + 32 * (w >> 2), c0 = 128 * (tile & 7) + 32 * (w & 3);
    const bf16_t* A = (const bf16_t*)(c.ws + WS_O) + (size_t)(NLAT + r0 + r32) * 1024 + 8 * hi;
    const bf16_t* B = (const bf16_t*)(c.ws + WS_BT_OUT) + ((size_t)l * 1024 + c0 + r32) * 1024 + 8 * hi;
    f32x16 acc = zero16();
#pragma unroll 8
    for (int s = 0; s < 64; ++s) { const bf16x8 af = *(const bf16x8*)(A + 16 * s), bf = *(const bf16x8*)(B + 16 * s); acc = __builtin_amdgcn_mfma_f32_32x32x16_bf16(af, bf, acc, 0, 0, 0); }
    bf16_t* xw = (bf16_t*)(c.ws + WS_XW) + (size_t)NLAT * 1024; const float* xs = c.P->in[I_CTX];
    const float gate = ((const float*)(c.ws + WS_MODS))[((size_t)l * 9 + 8) * 6144 + 2 * 1024 + c0 + r32];
#pragma unroll
    for (int r = 0; r < 16; ++r) { const size_t off = (size_t)(r0 + crow(r, hi)) * 1024 + c0 + r32; const float xo = l == 0 ? xs[off] : bf2f(xw[off]); xw[off] = (bf16_t)(cvtpk(xo + gate * acc[r], 0.f) & 0xffffu); }
}
}
namespace mk {
__device__ __forceinline__ int chunk_row(int b, int cidx, int& t0, int& len) { if (cidx < 2) { t0 = 128 * cidx; len = L; return NLAT + b * L + t0; } t0 = 128 * (cidx - 2); len = S; return b * S + t0; }

constexpr int SD_X = 0;
constexpr int SD_B = 65536;
constexpr int SD_C = 81920;
constexpr int SD_WT = 98304;
constexpr int SD_WV = 106496;
constexpr int SD_MISC = 110592;
constexpr int SD_SSQ = 110720;
constexpr int SD_BYTES = 114816;

template <bool WITH_C, bool B_TR> __device__ __forceinline__ void ssd_conv_stage(const Ctx& c, int l, int g, int rowbase, int t0, int len) {
    const Params& P = *c.P; const bf16_t* U = (const bf16_t*)(c.ws + WS_U);
    const float* cw = P.in[I_CONVW] + (size_t)l * 5 * 768; const float* cb = P.in[I_CONVB] + (size_t)l * 768;
    constexpr int NCG = WITH_C ? 48 : 40;
    const int tid_l = c.wave * 64 + lane_now();
    for (int it = tid_l; it < NCG * 16; it += NTHREADS) {
        const int cg = it % NCG, seg = it / NCG; const int tb = seg * 8;
        int ucol, ch, kind;
        if (cg < 32) { kind = 0; ch = (4 * g) * 64 + cg * 8; ucol = UX + ch; } else if (cg < 40) { kind = 1; ch = 512 + g * 64 + (cg - 32) * 8; ucol = UB + g * 64 + (cg - 32) * 8; } else { kind = 2; ch = 640 + g * 64 + (cg - 40) * 8; ucol = UC + g * 64 + (cg - 40) * 8; }
        float wt[5][8], bias[8];
#pragma unroll
        for (int j = 0; j < 5; ++j) { const f32x4 a = *(const f32x4*)(cw + j * 768 + ch), bq = *(const f32x4*)(cw + j * 768 + ch + 4); wt[j][0] = a.x; wt[j][1] = a.y; wt[j][2] = a.z; wt[j][3] = a.w; wt[j][4] = bq.x; wt[j][5] = bq.y; wt[j][6] = bq.z; wt[j][7] = bq.w; }
        { const f32x4 a = *(const f32x4*)(cb + ch), bq = *(const f32x4*)(cb + ch + 4); bias[0] = a.x; bias[1] = a.y; bias[2] = a.z; bias[3] = a.w; bias[4] = bq.x; bias[5] = bq.y; bias[6] = bq.z; bias[7] = bq.w; }
        u32x4 raw[12];
#pragma unroll
        for (int i = 0; i < 12; ++i) { const int tt = t0 + tb + i - 2; raw[i] = (tt >= 0 && tt < len) ? *(const u32x4*)(U + (size_t)(rowbase + tb + i - 2) * NU + ucol) : (u32x4){0u, 0u, 0u, 0u}; }
#pragma unroll
        for (int i = 0; i < 8; ++i) { float acc[8];
#pragma unroll
            for (int e = 0; e < 8; ++e) acc[e] = bias[e];
#pragma unroll
            for (int j = 0; j < 5; ++j) { const u32x4 rw = raw[i + j];
                acc[0] += bflo(rw.x) * wt[j][0]; acc[1] += bfhi(rw.x) * wt[j][1]; acc[2] += bflo(rw.y) * wt[j][2]; acc[3] += bfhi(rw.y) * wt[j][3];
                acc[4] += bflo(rw.z) * wt[j][4]; acc[5] += bfhi(rw.z) * wt[j][5]; acc[6] += bflo(rw.w) * wt[j][6]; acc[7] += bfhi(rw.w) * wt[j][7]; }
#pragma unroll
            for (int e = 0; e < 8; ++e) acc[e] = silu_f(acc[e]);
            u32x4 o; o.x = cvtpk(acc[0], acc[1]); o.y = cvtpk(acc[2], acc[3]); o.z = cvtpk(acc[4], acc[5]); o.w = cvtpk(acc[6], acc[7]);
            const int t = tb + i; int off;
            if (kind == 0) { const int hl = cg >> 3, p0 = (cg & 7) * 8; off = SD_X + hl * 16384 + (p0 >> 5) * 8192 + t * 64 + (p0 & 31) * 2; }
            else { const int n0 = ((kind == 1) ? (cg - 32) : (cg - 40)) * 8; const int base = (kind == 1) ? SD_B : SD_C;
                if (kind == 1 && B_TR) off = base + (n0 >> 5) * 8192 + t * 64 + (n0 & 31) * 2; else off = base + (n0 >> 3) * 2048 + t * 16; }
            *(LAS u32x4*)(c.lds + off) = o; }
    }
}
__device__ __forceinline__ void ssd_scan_stage(const Ctx& c, int l, int g, int rowbase) {
    const Params& P = *c.P; const float* dtv = (const float*)(c.ws + WS_DT);
    const int tid_l = c.wave * 64 + lane_now();
    const int hl = c.wave >> 1, dir = c.wave & 1, hh = 4 * g + hl, lane = tid_l & 63;
    const float a = -__expf(P.in[I_ALOG][l * 16 + dir * 8 + hh]);
    const float d0 = dtv[(size_t)(rowbase + 2 * lane) * 16 + dir * 8 + hh], d1 = dtv[(size_t)(rowbase + 2 * lane + 1) * 16 + dir * 8 + hh];
    const float x0 = d0 * a, x1 = d1 * a; float ps = x0 + x1, inc = ps;
    if (dir == 0) {
#pragma unroll
        for (int o = 1; o < 64; o <<= 1) { const float v = __shfl_up(inc, o); if (lane >= o) inc += v; }
    } else {
#pragma unroll
        for (int o = 1; o < 64; o <<= 1) { const float v = __shfl_down(inc, o); if (lane + o < 64) inc += v; }
    }
    const float ex = inc - ps;
    float a0, a1;
    if (dir == 0) { a0 = ex + x0; a1 = ex + ps; } else { a1 = ex + x1; a0 = ex + ps; }
    const float total = dir == 0 ? __shfl(inc, 63) : __shfl(inc, 0);
    LAS float* wt = (LAS float*)(c.lds + SD_WT) + hl * 512;
    wt[dir * 128 + 2 * lane] = a0; wt[dir * 128 + 2 * lane + 1] = a1; wt[256 + dir * 128 + 2 * lane] = __logf(d0) - a0; wt[256 + dir * 128 + 2 * lane + 1] = __logf(d1) - a1;
    LAS float* wv = (LAS float*)(c.lds + SD_WV) + (hl * 2 + dir) * 128;
    wv[2 * lane] = __expf(total - a0) * d0; wv[2 * lane + 1] = __expf(total - a1) * d1;
    if (lane == 0) ((LAS float*)(c.lds + SD_MISC))[hl * 2 + dir] = total;
}

__device__ __forceinline__ void ssd_s1_unit(const Ctx& c, int l, int b, int cidx, int g) {
    int t0, len; const int rowbase = chunk_row(b, cidx, t0, len);
    ssd_conv_stage<false, true>(c, l, g, rowbase, t0, len);
    ssd_scan_stage(c, l, g, rowbase);
    __syncthreads();
    const int tid_l = c.wave * 64 + lane_now();
    const int lane = tid_l & 63, hi = lane >> 5, hl = c.wave >> 1, dir = c.wave & 1, hh = 4 * g + hl;
    const LAS unsigned char* Xb = c.lds + SD_X + hl * 16384 + (4 * hi + ((lane & 15) >> 2)) * 64 + ((lane >> 4) & 1) * 32 + (lane & 3) * 8;
    const LAS unsigned char* Bb = c.lds + SD_B + (4 * hi + ((lane & 15) >> 2)) * 64 + ((lane >> 4) & 1) * 32 + (lane & 3) * 8;
    const LAS float* wv = (const LAS float*)(c.lds + SD_WV) + (hl * 2 + dir) * 128;
    f32x16 acc[2][2];
#pragma unroll
    for (int i = 0; i < 2; ++i) { acc[i][0] = zero16(); acc[i][1] = zero16(); }
#pragma unroll 2
    for (int ks = 0; ks < 8; ++ks) {
        const f32x4 w0 = *(const LAS f32x4*)(wv + 16 * ks + 4 * hi), w1 = *(const LAS f32x4*)(wv + 16 * ks + 8 + 4 * hi);
        bf16x8 xa[2], bb[2];
#pragma unroll
        for (int pt = 0; pt < 2; ++pt) { const s16x4 lo = lds_tr(Xb + pt * 8192 + ks * 1024), hi4 = lds_tr(Xb + pt * 8192 + ks * 1024 + 512);
            u32x4 t; t.x = cvtpk(bf2f((unsigned short)lo[0]) * w0.x, bf2f((unsigned short)lo[1]) * w0.y); t.y = cvtpk(bf2f((unsigned short)lo[2]) * w0.z, bf2f((unsigned short)lo[3]) * w0.w);
            t.z = cvtpk(bf2f((unsigned short)hi4[0]) * w1.x, bf2f((unsigned short)hi4[1]) * w1.y); t.w = cvtpk(bf2f((unsigned short)hi4[2]) * w1.z, bf2f((unsigned short)hi4[3]) * w1.w);
            xa[pt] = __builtin_bit_cast(bf16x8, t); }
#pragma unroll
        for (int nt = 0; nt < 2; ++nt) { const s16x4 lo = lds_tr(Bb + nt * 8192 + ks * 1024), hi4 = lds_tr(Bb + nt * 8192 + ks * 1024 + 512);
            bb[nt] = (bf16x8){lo[0], lo[1], lo[2], lo[3], hi4[0], hi4[1], hi4[2], hi4[3]}; }
#pragma unroll
        for (int pt = 0; pt < 2; ++pt)
#pragma unroll
            for (int nt = 0; nt < 2; ++nt) acc[pt][nt] = __builtin_amdgcn_mfma_f32_32x32x16_bf16(xa[pt], bb[nt], acc[pt][nt], 0, 0, 0);
    }
    float* ST = (float*)(c.ws + WS_ST) + ((((size_t)b * NCH + cidx) * 8 + hh) * 2 + dir) * 4096;
#pragma unroll
    for (int pt = 0; pt < 2; ++pt)
#pragma unroll
        for (int nt = 0; nt < 2; ++nt)
#pragma unroll
            for (int r = 0; r < 16; ++r) ST[(32 * pt + crow(r, hi)) * 64 + 32 * nt + (lane & 31)] = acc[pt][nt][r];
    if (lane == 0) ((float*)(c.ws + WS_TOT))[(((size_t)b * NCH + cidx) * 8 + hh) * 2 + dir] = ((const LAS float*)(c.lds + SD_MISC))[hl * 2 + dir];
    __syncthreads();
}

__device__ __forceinline__ int chain_chunk(int dir, int i) { return dir == 0 ? i : (i == 0 ? 1 : (i == 1 ? 0 : NCH + 1 - i)); }
__device__ __forceinline__ void ssd_s2_item(const Ctx& c, int item) {
    const int half = item & 1, chain = item >> 1, dir = chain & 1, hh = (chain >> 1) & 7, b = chain >> 4;
    const int tid_l = c.wave * 64 + lane_now();
    const int p = 32 * half + (tid_l >> 4), n = 4 * (tid_l & 15);
    const float* ST = (const float*)(c.ws + WS_ST); const float* TOT = (const float*)(c.ws + WS_TOT); bf16_t* PV = (bf16_t*)(c.ws + WS_PREV);
    f32x4 carry = {0.f, 0.f, 0.f, 0.f};
#pragma unroll 6
    for (int i = 0; i < NCH; ++i) { const int cidx = chain_chunk(dir, i); const size_t idx = (((size_t)b * NCH + cidx) * 8 + hh) * 2 + dir;
        const f32x4 s = *(const f32x4*)(ST + idx * 4096 + p * 64 + n); const float dec = __expf(TOT[idx]);
        u32x2 o; o.x = cvtpk(carry.x, carry.y); o.y = cvtpk(carry.z, carry.w); *(u32x2*)(PV + idx * 4096 + p * 64 + n) = o;
        carry = carry * dec + s; }
}

__device__ __forceinline__ void ssd_s3_unit(const Ctx& c, int l, int b, int cidx) {
    const Params& P = *c.P; const bf16_t* U = (const bf16_t*)(c.ws + WS_U); bf16_t* O = (bf16_t*)(c.ws + WS_O);
    int t0, len; const int rowbase = chunk_row(b, cidx, t0, len);
    const int tid_l = c.wave * 64 + lane_now();
    const int lane = tid_l & 63, r32 = lane & 31, hi = lane >> 5, hl = c.wave >> 1, qh2 = c.wave & 1;
#pragma unroll
    for (int g = 0; g < 2; ++g) {
        const int hh = 4 * g + hl;
        MK_TS(c, 1, 0); ssd_conv_stage<true, false>(c, l, g, rowbase, t0, len); MK_TS(c, 1, 1);
        MK_TS(c, 2, 0); ssd_scan_stage(c, l, g, rowbase);
        __syncthreads(); MK_TS(c, 2, 1);
        const LAS float* wt = (const LAS float*)(c.lds + SD_WT) + hl * 512;
        const LAS unsigned char* Xb = c.lds + SD_X + hl * 16384 + (4 * hi + ((lane & 15) >> 2)) * 64 + ((lane >> 4) & 1) * 32 + (lane & 3) * 8;
        const float dsk = P.in[I_SSDD][l * 8 + hh];
#pragma unroll
        for (int qt = 0; qt < 2; ++qt) {
            const int qtg = 2 * qh2 + qt, q = 32 * qtg + r32;
            const LAS unsigned char* cfp = c.lds + SD_C + hi * 2048 + q * 16;
            const float afq = wt[q], abq = wt[128 + q], lwfq = wt[256 + q], lwbq = wt[384 + q];
            f32x16 y[2]; y[0] = zero16(); y[1] = zero16();
            MK_TS(c, 3, 0);
#pragma unroll 1
            for (int jt = 0; jt < 4; ++jt) {
                f32x16 gt = zero16();
#pragma unroll
                for (int s = 0; s < 4; ++s) { const bf16x8 bfr = *(const LAS bf16x8*)(c.lds + SD_B + s * 4096 + hi * 2048 + (32 * jt + r32) * 16);
                    gt = __builtin_amdgcn_mfma_f32_32x32x16_bf16(bfr, *(const LAS bf16x8*)(cfp + s * 4096), gt, 0, 0, 0); }
                if (jt < qtg) {
#pragma unroll
                    for (int r = 0; r < 16; ++r) gt[r] *= __expf(afq + wt[256 + 32 * jt + crow(r, hi)]);
                } else if (jt > qtg) {
#pragma unroll
                    for (int r = 0; r < 16; ++r) gt[r] *= __expf(abq + wt[384 + 32 * jt + crow(r, hi)]);
                } else {
#pragma unroll
                    for (int r = 0; r < 16; ++r) { const int j = 32 * jt + crow(r, hi);
                        const float wv = j < q ? __expf(afq + wt[256 + j]) : (j > q ? __expf(abq + wt[384 + j]) : __expf(afq + lwfq) + __expf(abq + lwbq));
                        gt[r] *= wv; }
                }
                u32x4 m0 = {cvtpk(gt[0], gt[1]), cvtpk(gt[2], gt[3]), cvtpk(gt[4], gt[5]), cvtpk(gt[6], gt[7])}, m1 = {cvtpk(gt[8], gt[9]), cvtpk(gt[10], gt[11]), cvtpk(gt[12], gt[13]), cvtpk(gt[14], gt[15])};
                const bf16x8 pa0 = __builtin_bit_cast(bf16x8, m0), pa1 = __builtin_bit_cast(bf16x8, m1);
#pragma unroll
                for (int pt = 0; pt < 2; ++pt)
#pragma unroll
                    for (int s2 = 0; s2 < 2; ++s2) { const s16x4 lo = lds_tr(Xb + pt * 8192 + (2 * jt + s2) * 1024), h4 = lds_tr(Xb + pt * 8192 + (2 * jt + s2) * 1024 + 512);
                        const bf16x8 xa = {lo[0], lo[1], lo[2], lo[3], h4[0], h4[1], h4[2], h4[3]};
                        y[pt] = __builtin_amdgcn_mfma_f32_32x32x16_bf16(xa, s2 == 0 ? pa0 : pa1, y[pt], 0, 0, 0); }
            }
            MK_TS(c, 3, 1); MK_TS(c, 4, 0);
            const int ql = 64 * qh2 + 32 * qt + r32; const bf16_t* zrow = U + (size_t)(rowbase + ql) * NU + UZ + hh * 64 + 4 * hi;
#pragma unroll 1
            for (int dir = 0; dir < 2; ++dir) { const bf16_t* PV = (const bf16_t*)(c.ws + WS_PREV) + ((((size_t)b * NCH + cidx) * 8 + hh) * 2 + dir) * 4096;
                bf16x8 pf[2][4];
#pragma unroll
                for (int pt = 0; pt < 2; ++pt)
#pragma unroll
                    for (int s = 0; s < 4; ++s) pf[pt][s] = *(const bf16x8*)(PV + (32 * pt + r32) * 64 + 16 * s + 8 * hi);
                const float eq = __expf(dir == 0 ? afq : abq);
#pragma unroll
                for (int pt = 0; pt < 2; ++pt) { f32x16 tmp = zero16();
#pragma unroll
                    for (int s = 0; s < 4; ++s) tmp = __builtin_amdgcn_mfma_f32_32x32x16_bf16(pf[pt][s], *(const LAS bf16x8*)(cfp + s * 4096), tmp, 0, 0, 0);
#pragma unroll
                    for (int r = 0; r < 16; ++r) y[pt][r] += eq * tmp[r]; }
            }
            MK_TS(c, 4, 1); MK_TS(c, 5, 0);
            float ssq = 0.f;
            {
#pragma unroll
              for (int pt = 0; pt < 2; ++pt)
#pragma unroll
                for (int g4 = 0; g4 < 4; ++g4) { const int p0 = 32 * pt + 8 * g4 + 4 * hi;
                    const u32x2 zz_ = *(const u32x2*)(zrow + 32 * pt + 8 * g4);
                    const u32x2 xx = *(const LAS u32x2*)(c.lds + SD_X + hl * 16384 + (p0 >> 5) * 8192 + ql * 64 + (p0 & 31) * 2);
                    float v0 = (y[pt][4 * g4] + dsk * bflo(xx.x)) * silu_f(bflo(zz_.x)), v1 = (y[pt][4 * g4 + 1] + dsk * bfhi(xx.x)) * silu_f(bfhi(zz_.x));
                    float v2 = (y[pt][4 * g4 + 2] + dsk * bflo(xx.y)) * silu_f(bflo(zz_.y)), v3 = (y[pt][4 * g4 + 3] + dsk * bfhi(xx.y)) * silu_f(bfhi(zz_.y));
                    ssq += (v0 * v0 + v1 * v1) + (v2 * v2 + v3 * v3);
                    u32x2 o; o.x = cvtpk(v0, v1); o.y = cvtpk(v2, v3); *(u32x2*)(O + (size_t)(rowbase + ql) * 1024 + 256 + hh * 64 + 4 * hi + 32 * pt + 8 * g4) = o; }
              ssq += __shfl_xor(ssq, 32); if (hi == 0) ((LAS float*)(c.lds + SD_SSQ))[(g * 4 + hl) * 128 + ql] = ssq; }
        }
        MK_TS(c, 5, 1);
        __syncthreads();
    }
    MK_TS(c, 6, 0);
    asm volatile("s_waitcnt vmcnt(0)" ::: "memory");
#pragma unroll
    for (int qt = 0; qt < 2; ++qt) { const int q = 64 * qh2 + 32 * qt + r32; float sq = 0.f;
#pragma unroll
        for (int s8 = 0; s8 < 8; ++s8) sq += ((const LAS float*)(c.lds + SD_SSQ))[s8 * 128 + q];
        const float rstd = __builtin_amdgcn_rsqf(sq * (1.0f / 512.0f) + 1e-6f);
#pragma unroll
        for (int g = 0; g < 2; ++g) { const int hh = 4 * g + hl; const float* ng = P.in[I_SSDG] + l * 512 + hh * 64 + 4 * hi; bf16_t* orow = O + (size_t)(rowbase + q) * 1024 + 256 + hh * 64 + 4 * hi;
            u32x2 v[2][4];
#pragma unroll
            for (int pt = 0; pt < 2; ++pt)
#pragma unroll
                for (int g4 = 0; g4 < 4; ++g4) v[pt][g4] = *(const u32x2*)(orow + 32 * pt + 8 * g4);
#pragma unroll
            for (int pt = 0; pt < 2; ++pt)
#pragma unroll
                for (int g4 = 0; g4 < 4; ++g4) { const f32x4 gg = *(const f32x4*)(ng + 32 * pt + 8 * g4); const u32x2 vv = v[pt][g4];
                    u32x2 o; o.x = cvtpk(bflo(vv.x) * rstd * gg.x, bfhi(vv.x) * rstd * gg.y); o.y = cvtpk(bflo(vv.y) * rstd * gg.z, bfhi(vv.y) * rstd * gg.w);
                    *(u32x2*)(orow + 32 * pt + 8 * g4) = o; } } }
    __syncthreads(); MK_TS(c, 6, 1);
}
}
namespace mk {
constexpr int LC_HIST = 16, LC_BASE = 48, LC_OFF = 80, LC_NT = 120;

__device__ __forceinline__ void router_table_fill(const Ctx& c, int l) {
    const Params& P = *c.P; const int tid_l = c.wave * 64 + lane_now(); LAS f32x4* rw = (LAS f32x4*)c.lds;
    const float* wg = P.in[I_WRG] + (size_t)l * 1024 * 4; const float* we = P.in[I_WRE] + (size_t)l * 1024 * 32;
    __syncthreads();
    for (int i = tid_l; i < 1024 * 9; i += NTHREADS) { const int k = i / 9, q = i % 9; const f32x4 v = q == 0 ? *(const f32x4*)(wg + k * 4) : *(const f32x4*)(we + k * 32 + (q - 1) * 4); rw[q * 1024 + k] = v; }
}
__device__ __forceinline__ void dt_table_fill(const Ctx& c, int l_next) {
    const int tid_l = c.wave * 64 + lane_now(); const float* wdt_g = (const float*)(c.ws + WS_WDT) + (size_t)l_next * 16 * 1024;
    __syncthreads();
    for (int i = tid_l; i < 16 * 256; i += NTHREADS) ((LAS f32x4*)c.lds)[i] = ((const f32x4*)wdt_g)[i];
}
__device__ __forceinline__ void phase_router(const Ctx& c, int l, int nrows, int cnt_slot) {
    const Params& P = *c.P; const bf16_t* xw = (const bf16_t*)(c.ws + WS_XW); bf16_t* H = (bf16_t*)(c.ws + WS_H);
    const float* mods = (const float*)(c.ws + WS_MODS) + (size_t)l * 9 * 6144;
    const int tid_l = c.wave * 64 + lane_now(); const int lane = tid_l & 63;
    volatile LAS unsigned* lctl = (volatile LAS unsigned*)(c.lds + LDS_CTL_OFF);
    LAS f32x4* rw = (LAS f32x4*)c.lds;
    if (tid_l < 32) lctl[LC_HIST + tid_l] = 0u;
    __syncthreads();
    const float* gf = P.in[I_GFFN] + l * 1024;
    int* SEL = (int*)(c.ws + WS_ROUTE + RT_SEL); int* POS = (int*)(c.ws + WS_ROUTE + RT_POS); float* RW = (float*)(c.ws + WS_ROUTE + RT_W);
    const int gw = c.bid * NWAVES + c.wave, NGW = c.G * NWAVES;
    int my_e0 = 0, my_e1 = 0, my_p0 = 0, my_p1 = 0, nmine = 0;
    for (int row = gw; row < nrows; row += NGW, ++nmine) {
        const int bb = row < NLAT ? row >> 11 : 8; const float* shift = mods + bb * 6144 + 3 * 1024 + lane; const float* scale = mods + bb * 6144 + 4 * 1024 + lane;
        const bf16_t* xr = xw + (size_t)row * 1024 + lane; float v[16]; float ss = 0.f;
#pragma unroll
        for (int m = 0; m < 16; ++m) { v[m] = bf2f(xr[64 * m]); ss += v[m] * v[m]; }
        const float rstd = __builtin_amdgcn_rsqf(wave_sum(ss) * (1.0f / 1024.0f) + 1e-6f);
        bf16_t* hr = H + (size_t)row * 1024 + lane;
#pragma unroll
        for (int m = 0; m < 16; ++m) { v[m] = (v[m] * rstd) * gf[lane + 64 * m] * (scale[64 * m] + 1.0f) + shift[64 * m]; hr[64 * m] = (bf16_t)(cvtpk(v[m], v[m]) & 0xffffu); }
        float acc[36];
#pragma unroll
        for (int q = 0; q < 36; ++q) acc[q] = 0.f;
#pragma unroll
        for (int m = 0; m < 16; ++m) { const float hv = v[m];
#pragma unroll
            for (int q = 0; q < 9; ++q) { const f32x4 w4 = rw[q * 1024 + lane + 64 * m]; acc[4 * q] += hv * w4.x; acc[4 * q + 1] += hv * w4.y; acc[4 * q + 2] += hv * w4.z; acc[4 * q + 3] += hv * w4.w; }
            if (m & 1) __builtin_amdgcn_sched_barrier(0); }
#pragma unroll
        for (int q = 0; q < 4; ++q) acc[q] = wave_sum(acc[q]) + P.in[I_BRG][l * 4 + q];
        float ea[16], eb[16];
#pragma unroll
        for (int q = 0; q < 16; ++q) { ea[q] = acc[4 + q]; eb[q] = acc[20 + q]; }
        const int jd_l = ((lane >> 5) & 1) * 8 + ((lane >> 4) & 1) * 4 + ((lane >> 3) & 1) * 2 + ((lane >> 2) & 1);
        const float ta = reduce16_transposed(ea, lane) + P.in[I_BRE][l * 32 + jd_l], tb = reduce16_transposed(eb, lane) + P.in[I_BRE][l * 32 + 16 + jd_l];
        int gi = 0; float gm = acc[0];
#pragma unroll
        for (int j = 1; j < 4; ++j) if (acc[j] > gm) { gm = acc[j]; gi = j; }
        float gs = 0.f;
#pragma unroll
        for (int j = 0; j < 4; ++j) gs += __expf(acc[j] - gm);
        const float gwt = 1.0f / gs;
        float el[8];
#pragma unroll
        for (int j = 0; j < 8; ++j) { const int jd = (gi & 1) * 8 + j; const int src = ((jd >> 3) & 1) * 32 + ((jd >> 2) & 1) * 16 + ((jd >> 1) & 1) * 8 + (jd & 1) * 4;
            const float fa = __shfl(ta, src), fb = __shfl(tb, src); el[j] = gi >= 2 ? fb : fa; }
        int i0 = 0; float v0 = el[0];
#pragma unroll
        for (int j = 1; j < 8; ++j) if (el[j] > v0) { v0 = el[j]; i0 = j; }
        int i1 = -1; float v1 = 0.f;
#pragma unroll
        for (int j = 0; j < 8; ++j) if (j != i0 && (i1 < 0 || el[j] > v1)) { v1 = el[j]; i1 = j; }
        const float e1 = __expf(v1 - v0); const float w0 = gwt / (1.0f + e1), w1 = gwt * e1 / (1.0f + e1);
        const int ex0 = gi * 8 + i0, ex1 = gi * 8 + i1;
        int lp0 = 0, lp1 = 0;
        if (lane == 0) { lp0 = (int)__hip_atomic_fetch_add((LAS unsigned*)(c.lds + LDS_CTL_OFF) + LC_HIST + ex0, 1u, __ATOMIC_RELAXED, __HIP_MEMORY_SCOPE_WORKGROUP);
                         lp1 = (int)__hip_atomic_fetch_add((LAS unsigned*)(c.lds + LDS_CTL_OFF) + LC_HIST + ex1, 1u, __ATOMIC_RELAXED, __HIP_MEMORY_SCOPE_WORKGROUP);
                         SEL[row * 2] = ex0; SEL[row * 2 + 1] = ex1; RW[row * 2] = w0; RW[row * 2 + 1] = w1; }
        lp0 = __shfl(lp0, 0); lp1 = __shfl(lp1, 0);
        if (lane == nmine) { my_e0 = ex0; my_e1 = ex1; my_p0 = lp0; my_p1 = lp1; }
    }
    __syncthreads();
    unsigned* ctlw = (unsigned*)(c.ws + WS_CTL);
    unsigned* cnt = ctlw + CW_CNT + 64 * cnt_slot; unsigned* pool = ctlw + CW_POOL + 64 * cnt_slot; unsigned* tof = ctlw + CW_TOF + 8192 * cnt_slot;
    int* tile_e = (int*)(c.ws + WS_ROUTE + RT_TILE_E);
    if (tid_l < 32) { const unsigned h = lctl[LC_HIST + tid_l]; unsigned base = 0;
        if (h) { base = __hip_atomic_fetch_add(cnt + tid_l, h, __ATOMIC_RELAXED, __HIP_MEMORY_SCOPE_AGENT);
            for (unsigned j = (base + 255u) >> 8; (j << 8) < base + h; ++j) { const unsigned t = __hip_atomic_fetch_add(pool, 1u, __ATOMIC_RELAXED, __HIP_MEMORY_SCOPE_AGENT);
                tile_e[t] = tid_l; __hip_atomic_store(tof + tid_l * 144 + j, t + 1u, __ATOMIC_RELAXED, __HIP_MEMORY_SCOPE_AGENT); } }
        lctl[LC_BASE + tid_l] = base; }
    __syncthreads();
    int* SLOT = (int*)(c.ws + WS_ROUTE + RT_SLOT); bf16_t* HS = (bf16_t*)(c.ws + WS_U);
    int ms0 = 0, ms1 = 0;
    if (lane < nmine) { const int row = gw + lane * NGW;
        const unsigned p0 = lctl[LC_BASE + my_e0] + (unsigned)my_p0, p1 = lctl[LC_BASE + my_e1] + (unsigned)my_p1;
        unsigned t0 = 0, t1 = 0;
        for (unsigned sp = 0; sp < (1u << 22); ++sp) { if (!t0) t0 = __hip_atomic_load(tof + my_e0 * 144 + (p0 >> 8), __ATOMIC_RELAXED, __HIP_MEMORY_SCOPE_AGENT); if (!t1) t1 = __hip_atomic_load(tof + my_e1 * 144 + (p1 >> 8), __ATOMIC_RELAXED, __HIP_MEMORY_SCOPE_AGENT);
            if (t0 && t1) break; __builtin_amdgcn_s_sleep(1); }
        ms0 = (int)(((t0 ? t0 : 1u) - 1u) * 256u + (p0 & 255u)); ms1 = (int)(((t1 ? t1 : 1u) - 1u) * 256u + (p1 & 255u));
        SLOT[row * 2] = ms0; SLOT[row * 2 + 1] = ms1; }
    asm volatile("s_waitcnt vmcnt(0)" ::: "memory");
    for (int i = 0; i < nmine; ++i) { const int row = gw + i * NGW; const int s0 = __shfl(ms0, i), s1 = __shfl(ms1, i);
        const u32x4* src = (const u32x4*)(H + (size_t)row * 1024) + lane; const u32x4 a = src[0], bq = src[64];
        u32x4* d0 = (u32x4*)(HS + (size_t)s0 * 1024) + lane; u32x4* d1 = (u32x4*)(HS + (size_t)s1 * 1024) + lane;
        d0[0] = a; d0[64] = bq; d1[0] = a; d1[64] = bq; }
    __syncthreads();
}

__device__ __forceinline__ void phase_sort(const Ctx& c, int l, int nrows) {
    const int tid_l = c.wave * 64 + lane_now(); const int lane = tid_l & 63;
    volatile LAS unsigned* lctl = (volatile LAS unsigned*)(c.lds + LDS_CTL_OFF);
    const unsigned* cnt = (const unsigned*)(c.ws + WS_CTL) + CW_CNT + 64 * l;
    int* tile_e = (int*)(c.ws + WS_ROUTE + RT_TILE_E); int* ntl = (int*)(c.ws + WS_ROUTE + RT_NTILES);
    if (tid_l == 0) { unsigned off = 0;
#pragma unroll 1
        for (int e = 0; e < 32; ++e) { const unsigned n = __hip_atomic_load(cnt + e, __ATOMIC_RELAXED, __HIP_MEMORY_SCOPE_AGENT); lctl[LC_OFF + e] = off; const unsigned nt = (n + 255u) >> 8;
            if (c.bid == 0) {
#pragma unroll 1
                for (unsigned t = 0; t < nt; ++t) tile_e[(off >> 8) + t] = e; }
            off += nt << 8; }
        if (c.bid == 0) ntl[0] = (int)(off >> 8); }
    __syncthreads();
    const int* SEL = (const int*)(c.ws + WS_ROUTE + RT_SEL); const int* POS = (const int*)(c.ws + WS_ROUTE + RT_POS); int* SLOT = (int*)(c.ws + WS_ROUTE + RT_SLOT);
    const bf16_t* H = (const bf16_t*)(c.ws + WS_H); bf16_t* HS = (bf16_t*)(c.ws + WS_U);
    const int gw = c.bid * NWAVES + c.wave, NGW = c.G * NWAVES;
    for (int row = gw; row < nrows; row += NGW) {
        const int s0 = (int)lctl[LC_OFF + SEL[row * 2]] + POS[row * 2], s1 = (int)lctl[LC_OFF + SEL[row * 2 + 1]] + POS[row * 2 + 1];
        if (lane == 0) { SLOT[row * 2] = s0; SLOT[row * 2 + 1] = s1; }
        const u32x4* src = (const u32x4*)(H + (size_t)row * 1024) + lane; const u32x4 a = src[0], b = src[64];
        u32x4* d0 = (u32x4*)(HS + (size_t)s0 * 1024) + lane; u32x4* d1 = (u32x4*)(HS + (size_t)s1 * 1024) + lane;
        d0[0] = a; d0[64] = b; d1[0] = a; d1[64] = b;
    }
    __syncthreads();
}

struct CombRow { u32x2 x[4]; u32x2 a[4], b[4]; float w0, w1; int bb; };
__device__ __forceinline__ void comb_load(CombRow& r, int row, int s0, int s1, float w0, float w1, const bf16_t* xw, const bf16_t* OS, int lane) {
    r.w0 = w0; r.w1 = w1; r.bb = row < NLAT ? row >> 11 : 8;
#pragma unroll
    for (int j = 0; j < 4; ++j) { r.x[j] = ((const u32x2*)(xw + (size_t)row * 1024))[lane + 64 * j]; r.a[j] = __builtin_nontemporal_load((const u32x2*)(OS + (size_t)s0 * 1024) + lane + 64 * j); r.b[j] = __builtin_nontemporal_load((const u32x2*)(OS + (size_t)s1 * 1024) + lane + 64 * j); }
}
__device__ __forceinline__ void comb_finish(const Ctx& c, CombRow& r, int row, int l, bool last, bool store_x, const LAS float* wdt, int lane) {
    const Params& P = *c.P; bf16_t* xw = (bf16_t*)(c.ws + WS_XW); const float* mods = (const float*)(c.ws + WS_MODS) + (size_t)l * 9 * 6144;
    const float* gate = mods + r.bb * 6144 + 5 * 1024; f32x4 v[4]; float ss = 0.f;
#pragma unroll
    for (int j = 0; j < 4; ++j) { const f32x4 gg = ((const f32x4*)gate)[lane + 64 * j]; f32x4 x; x.x = bflo(r.x[j].x); x.y = bfhi(r.x[j].x); x.z = bflo(r.x[j].y); x.w = bfhi(r.x[j].y); const u32x2 a = r.a[j], bq = r.b[j]; const float w0 = r.w0, w1 = r.w1;
        x.x += gg.x * (w0 * bflo(a.x) + w1 * bflo(bq.x)); x.y += gg.y * (w0 * bfhi(a.x) + w1 * bfhi(bq.x)); x.z += gg.z * (w0 * bflo(a.y) + w1 * bflo(bq.y)); x.w += gg.w * (w0 * bfhi(a.y) + w1 * bfhi(bq.y));
        v[j] = x; ss += (x.x * x.x + x.y * x.y) + (x.z * x.z + x.w * x.w); if (!last && store_x) { u32x2 o; o.x = cvtpk(x.x, x.y); o.y = cvtpk(x.z, x.w); ((u32x2*)(xw + (size_t)row * 1024))[lane + 64 * j] = o; } }
    const float rstd = __builtin_amdgcn_rsqf(wave_sum(ss) * (1.0f / 1024.0f) + 1e-6f);
    if (last) {
#pragma unroll
        for (int j = 0; j < 4; ++j) { const f32x4 gg = ((const f32x4*)P.in[I_GFIN])[lane + 64 * j]; ((f32x4*)(P.out + (size_t)row * 1024))[lane + 64 * j] = (v[j] * rstd) * gg; }
    } else {
        const float* modn = (const float*)(c.ws + WS_MODS) + (size_t)(l + 1) * 9 * 6144; bf16_t* H = (bf16_t*)(c.ws + WS_H); float* dtv = (float*)(c.ws + WS_DT);
        const float* g = P.in[I_GMIX] + (l + 1) * 1024; const float* shift = modn + r.bb * 6144; const float* scale = modn + r.bb * 6144 + 1024;
#pragma unroll
        for (int j = 0; j < 4; ++j) { const f32x4 gg = ((const f32x4*)g)[lane + 64 * j], sh = ((const f32x4*)shift)[lane + 64 * j], sl = ((const f32x4*)scale)[lane + 64 * j];
            v[j] = (v[j] * rstd) * gg * (sl + 1.0f) + sh;
            u32x2 o; o.x = cvtpk(v[j].x, v[j].y); o.y = cvtpk(v[j].z, v[j].w); ((u32x2*)(H + (size_t)row * 1024))[lane + 64 * j] = o; }
        float pa[16];
#pragma unroll
        for (int jd = 0; jd < 16; ++jd) { float a = 0.f;
#pragma unroll
            for (int j = 0; j < 4; ++j) { const f32x4 w = ((const LAS f32x4*)(wdt + jd * 1024))[lane + 64 * j]; a += (v[j].x * w.x + v[j].y * w.y) + (v[j].z * w.z + v[j].w * w.w); }
            pa[jd] = a; if ((jd & 3) == 3) __builtin_amdgcn_sched_barrier(0); }
        const float tot = reduce16_transposed(pa, lane); const int jd_l = ((lane >> 5) & 1) * 8 + ((lane >> 4) & 1) * 4 + ((lane >> 3) & 1) * 2 + ((lane >> 2) & 1);
        if ((lane & 3) == 0) dtv[(size_t)row * 16 + jd_l] = softplus_f(tot + P.in[I_DTB][(l + 1) * 16 + jd_l]);
    }
}
__device__ __forceinline__ void phase_combine(const Ctx& c, int l, int nrows, bool store_x) {
    const bf16_t* xw = (const bf16_t*)(c.ws + WS_XW); const bf16_t* OS = (const bf16_t*)(c.ws + WS_U);
    const int* SLOT = (const int*)(c.ws + WS_ROUTE + RT_SLOT); const float* RW = (const float*)(c.ws + WS_ROUTE + RT_W);
    const int tid_l = c.wave * 64 + lane_now(); const int lane = tid_l & 63;
    const int gw = c.bid * NWAVES + c.wave, NGW = c.G * NWAVES;
    const bool last = (l == DEPTH - 1);
    LAS float* wdt = (LAS float*)c.lds;
    __syncthreads();
    int ms0 = 0, ms1 = 0; float mw0 = 0.f, mw1 = 0.f;
    { const int myrow = gw + lane * NGW; if (myrow < nrows) { ms0 = SLOT[myrow * 2]; ms1 = SLOT[myrow * 2 + 1]; mw0 = RW[myrow * 2]; mw1 = RW[myrow * 2 + 1]; } }
    int row = gw, i = 0;
    for (; row + NGW < nrows; row += 2 * NGW, i += 2) {
        CombRow r0, r1;
        comb_load(r0, row, __shfl(ms0, i), __shfl(ms1, i), __shfl(mw0, i), __shfl(mw1, i), xw, OS, lane);
        comb_load(r1, row + NGW, __shfl(ms0, i + 1), __shfl(ms1, i + 1), __shfl(mw0, i + 1), __shfl(mw1, i + 1), xw, OS, lane);
        comb_finish(c, r0, row, l, last, store_x, wdt, lane); comb_finish(c, r1, row + NGW, l, last, store_x, wdt, lane);
    }
    if (row < nrows) { CombRow r0; comb_load(r0, row, __shfl(ms0, i), __shfl(ms1, i), __shfl(mw0, i), __shfl(mw1, i), xw, OS, lane); comb_finish(c, r0, row, l, last, store_x, wdt, lane); }
}
}
namespace mk {
constexpr int NPH = 10, PH_TOTAL = 2 + DEPTH * NPH;
__global__ void __launch_bounds__(NTHREADS, 2) mk_fwd(Params P, int ph_lo, int ph_hi) {
    extern __shared__ __attribute__((aligned(16))) unsigned char lds_raw[];
    Ctx c0; c0.lds = (LAS unsigned char*)lds_raw; c0.wave = __builtin_amdgcn_readfirstlane((int)threadIdx.x >> 6); c0.G = gridDim.x; c0.bid = blockIdx.x; c0.P = &P; c0.ws = P.ws;
    volatile LAS unsigned* lctl = (volatile LAS unsigned*)(c0.lds + LDS_CTL_OFF);
    if (threadIdx.x < 256) lctl[threadIdx.x] = 0u;
    __syncthreads();
    unsigned* ctl = (unsigned*)(c0.ws + WS_CTL);
    XcdBarrier bar; bar.bar = ctl + CW_BAR; bar.x = 0; bar.st = lctl;
    const bool one_launch = (ph_hi - ph_lo) > 1;
    if (one_launch) bar = xcd_barrier_post(ctl + CW_BAR, lctl);
#ifndef MK_DUP
#define MK_DUP -1
#endif
#define NREP(k) ((MK_DUP >= 0 && (((k) < 2) ? (k) == MK_DUP : (((k) - 2) % NPH) + 2 == MK_DUP)) ? 2 : 1)
#define PH(k) if (ph_lo <= (k) && (k) < ph_hi) for (int rep_ = 0; rep_ < NREP(k); ++rep_, body_end(k))
#define DUMMY(k) (NREP(k) == 2 && rep_ == 0)
#ifndef MK_STAMP
#define MK_STAMP -1
#endif
#ifdef MK_SUB
#define defined_MK_SUB 1
#else
#define defined_MK_SUB 0
#endif
    unsigned long long t_prev = 0ull, t_acc = 0ull; if (MK_STAMP >= 0) t_prev = __builtin_amdgcn_s_memrealtime();
    auto body_end = [&](int k) { if (MK_STAMP >= 100) { asm volatile("s_waitcnt vmcnt(0) lgkmcnt(0)" ::: "memory"); const unsigned long long now_ = __builtin_amdgcn_s_memrealtime(); if ((((k) < 2) ? (k) : (((k) - 2) % NPH) + 2) == (MK_STAMP % 100)) t_acc += now_ - t_prev; } };
#define PTYPE(k) (((k) < 2) ? (k) : (((k) - 2) % NPH) + 2)
#define SEAM(k) do { if (ph_lo <= (k) && (k) + 1 < ph_hi) { xcd_barrier(bar); if (MK_DUP == 100) xcd_barrier(bar); } \
    if (MK_STAMP >= 0) { const unsigned long long now_ = __builtin_amdgcn_s_memrealtime(); if (MK_STAMP < 100 && (PTYPE(k) == MK_STAMP || MK_STAMP == 99)) t_acc += now_ - t_prev; t_prev = now_; } } while (0)
    PH(0) { const Ctx c = fresh(c0); phase_p0a(c); } SEAM(0);
    PH(1) { const Ctx c = fresh(c0); phase_norm1(c, 0, c.P->in[I_X], c.P->in[I_CTX]); } SEAM(1);
    for (int l = 0; l < DEPTH; ++l) {
        const int pb = 2 + l * NPH; const bool need_ctx = l < DEPTH - 1;
        PH(pb + 0) { const Ctx c = fresh(c0);
            pg8::Gemm g{(const pg8::bf16_t*)(c.ws + WS_H), (const pg8::bf16_t*)(c.ws + WS_BT_IN) + (size_t)l * NU * 1024, NT, NU, 1024};
            pg8::StaticOrder So; So.init(NT, NU, c.G, c.bid);
            EpiInProj E{(bf16_t*)(c.ws + WS_U), (const f32x2*)(c.ws + WS_ROPE)};
            pg8::gemm_phase<EpiInProj, pg8::StaticOrder, false>((PG8_LAS unsigned char*)c.lds, g, So, E, nullptr, c.wave);
        } SEAM(pb + 0);
        constexpr int NGQA3 = 32;
        PH(pb + 1) { const Ctx c = fresh(c0);
            for (int i = c.bid; i < 288 + 256 - NGQA3; i += c.G) {
                if (i < 288) { const int b = i / 36, rem = i % 36; ssd_s1_unit(c, l, b, rem >> 1, rem & 1); }
                else { const int k = i - 288; attn_unit<0>(c, l, k >> 5, (k & 31) >> 1, k & 1); } }
        } SEAM(pb + 1);
        PH(pb + 2) { const Ctx c = fresh(c0);
            for (int i = c.bid; i < 256; i += c.G) ssd_s2_item(c, i);
        } SEAM(pb + 2);
        PH(pb + 3) { const Ctx c = fresh(c0);
            const int ns3 = need_ctx ? 144 : 128; const int nrest = NGQA3 + 256 + (need_ctx ? 64 : 0);
            if (c.bid < ns3) { if (need_ctx) ssd_s3_unit(c, l, c.bid / 18, c.bid % 18); else ssd_s3_unit(c, l, c.bid >> 4, 2 + (c.bid & 15)); }
            else if (c.G > ns3) {
                for (int k = c.bid - ns3; k < nrest; k += c.G - ns3) {
                    if (k < NGQA3) { const int k0 = 256 - NGQA3 + k; attn_unit<0>(c, l, k0 >> 5, (k0 & 31) >> 1, k0 & 1); }
                    else if (k < NGQA3 + 256) { const int k1 = k - NGQA3; attn_unit<1>(c, l, k1 >> 5, (k1 & 31) >> 2, k1 & 3); }
                    else { const int k2 = k - NGQA3 - 256; attn_unit<2>(c, l, k2 >> 3, k2 & 7, 0); } } }
        } SEAM(pb + 3);
        PH(pb + 4) { const Ctx c = fresh(c0);
            pg8::Gemm g{(const pg8::bf16_t*)(c.ws + WS_O), (const pg8::bf16_t*)(c.ws + WS_BT_OUT) + (size_t)l * 1024 * 1024, NLAT, 1024, 1024};
            pg8::StaticOrder So; So.init(NLAT, 1024, c.G, c.bid);
            EpiOutProj E{c.P->in[I_X], c.P->in[I_CTX], (bf16_t*)(c.ws + (DUMMY(pb + 4) ? WS_U : WS_XW)), (const float*)(c.ws + WS_MODS) + (size_t)l * 9 * 6144, l == 0};
            pg8::gemm_phase<EpiOutProj, pg8::StaticOrder, false>((PG8_LAS unsigned char*)c.lds, g, So, E, nullptr, c.wave);
            if (need_ctx && !DUMMY(pb + 4)) for (int t = c.bid; t < 256; t += c.G) ctx_outproj_tile(c, l, t);
            router_table_fill(c, l);
        } SEAM(pb + 4);
        const int nrows = need_ctx ? NT : NLAT;
        PH(pb + 5) { const Ctx c = fresh(c0); phase_router(c, l, nrows, DUMMY(pb + 5) ? l + 4 : l); } SEAM(pb + 5);
        PH(pb + 7) { const Ctx c = fresh(c0);
            const int ntiles = __builtin_amdgcn_readfirstlane((int)__hip_atomic_load((const unsigned*)(c.ws + WS_CTL) + CW_POOL + 64 * l, __ATOMIC_RELAXED, __HIP_MEMORY_SCOPE_AGENT));
            pg8::Gemm g{(const pg8::bf16_t*)(c.ws + WS_U), (const pg8::bf16_t*)(c.ws + WS_BT_GU) + (size_t)l * 32 * 512 * 1024, ntiles * 256, 512, 1024};
            ExpertOrder<2> So{(const int*)(c.ws + WS_ROUTE + RT_TILE_E), ntiles, c.G, c.bid};
            EpiGateUp E{(bf16_t*)(c.ws + WS_HID)};
            pg8::gemm_phase<EpiGateUp, ExpertOrder<2>, false>((PG8_LAS unsigned char*)c.lds, g, So, E, nullptr, c.wave);
        } SEAM(pb + 7);
        PH(pb + 8) { const Ctx c = fresh(c0);
            const int ntiles = __builtin_amdgcn_readfirstlane((int)__hip_atomic_load((const unsigned*)(c.ws + WS_CTL) + CW_POOL + 64 * l, __ATOMIC_RELAXED, __HIP_MEMORY_SCOPE_AGENT));
            pg8::Gemm g{(const pg8::bf16_t*)(c.ws + WS_HID), (const pg8::bf16_t*)(c.ws + WS_BT_DN) + (size_t)l * 32 * 1024 * 256, ntiles * 256, 1024, 256};
            ExpertOrder<4> So{(const int*)(c.ws + WS_ROUTE + RT_TILE_E), ntiles, c.G, c.bid};
            EpiDown E{(bf16_t*)(c.ws + WS_U)};
            pg8::gemm_phase<EpiDown, ExpertOrder<4>, false>((PG8_LAS unsigned char*)c.lds, g, So, E, nullptr, c.wave);
            if (l + 1 < DEPTH) dt_table_fill(c, l + 1);
        } SEAM(pb + 8);
        PH(pb + 9) { const Ctx c = fresh(c0); phase_combine(c, l, nrows, !DUMMY(pb + 9)); } SEAM(pb + 9);
    }
#ifdef MK_SUB
    if (c0.bid == 0) { __syncthreads(); t_acc = *(volatile LAS unsigned long long*)(c0.lds + LDS_CTL_OFF + 512 + 8); }
#endif
    if ((MK_STAMP >= 0 || defined_MK_SUB) && c0.bid == (MK_STAMP >= 200 ? (int)gridDim.x - 1 : 0)) { const unsigned long long t0 = __builtin_amdgcn_s_memrealtime(); while (__builtin_amdgcn_s_memrealtime() - t0 < t_acc) __builtin_amdgcn_s_sleep(8); }
#undef PH
#undef SEAM
}

static int g_grid = 0;
static void mk_setup() {
    if (g_grid) return;
    int dev = 0, cus = 0; hipGetDevice(&dev); hipDeviceGetAttribute(&cus, hipDeviceAttributeMultiprocessorCount, dev);
    if (hipFuncSetAttribute((const void*)mk_fwd, hipFuncAttributeMaxDynamicSharedMemorySize, LDS_BYTES) != hipSuccess) { fprintf(stderr, "hipFuncSetAttribute failed\n"); g_grid = -1; return; }
    int per_cu = 0; (void)hipOccupancyMaxActiveBlocksPerMultiprocessor(&per_cu, (const void*)mk_fwd, NTHREADS, LDS_BYTES); (void)hipGetLastError();
    g_grid = cus;
}
static void mk_launch(const Params& P, int lo, int hi, hipStream_t stream) {
    hipLaunchKernelGGL(mk_fwd, dim3(g_grid), dim3(NTHREADS), LDS_BYTES, stream, P, lo, hi);
}
}

extern "C" void kernel_launch(void* const* d_in, const int* in_sizes, int n_in, void* d_out, int out_size, void* d_ws, size_t ws_size, hipStream_t stream) {
    mk::mk_setup(); if (mk::g_grid <= 0) return;
    if (ws_size < mk::WS_END) { fprintf(stderr, "workspace too small\n"); return; }
    unsigned char* ws = (unsigned char*)d_ws;
    hipMemsetAsync(ws + mk::WS_CTL, 0, mk::CTL_BYTES, stream);
    mk::Params MP{}; for (int i = 0; i < 26; ++i) MP.in[i] = (const float*)d_in[i]; MP.out = (float*)d_out; MP.ws = ws;
    mk::mk_launch(MP, 0, mk::PH_TOTAL, stream);
}
```
